# Optimizing an MI355X kernel written in HIP

```python
import math, functools
import jax, jax.numpy as jnp
from jax import lax
import numpy as np

D_MODEL = 1024
BATCH = 8
SEQ = 2048
DEPTH = 1
DEC_BATCH = 128
DEC_SEQ = 8
PAST_LEN = 2048
PAGE_SIZE = 128

HEAD_DIM = 64
D_MIX = D_MODEL
D_ATTN = D_MIX // 2
D_SSD = D_MIX - D_ATTN
N_ATTN_HEADS = D_ATTN // HEAD_DIM
N_SSD_HEADS = D_SSD // HEAD_DIM
SSD_GROUPS = 2
HEADS_PER_GROUP = N_SSD_HEADS // SSD_GROUPS
D_STATE = 128
CONV_W = 4
CONV_DIM = D_SSD + 2 * SSD_GROUPS * D_STATE
SSD_CHUNK = 128
DILATED_PAIRS = ((128, 1), (512, 4), (2048, 16))
MAX_WINDOW = 2048
D_FF = 4 * D_MODEL
D_PLE = 256
LN_EPS = 1e-5
DEEPNORM_ALPHA = (2 * DEPTH) ** 0.25
DEEPNORM_BETA = (8 * DEPTH) ** -0.25
D_IN_PROJ = 3 * D_ATTN + D_SSD + CONV_DIM + N_SSD_HEADS
IN_SPLITS = [D_ATTN, 2 * D_ATTN, 3 * D_ATTN, 3 * D_ATTN + D_SSD, 3 * D_ATTN + D_SSD + CONV_DIM]

kernel_name = "hymba_dilated_ssd_deepnorm_step"


def alibi_slopes(n_heads):
    return np.array([2.0 ** (-8.0 * (h + 1) / n_heads) for h in range(n_heads)], dtype=np.float32)


def layer_norm(x, g, b):
    xf = x.astype(jnp.float32)
    mu = jnp.mean(xf, -1, keepdims=True)
    var = jnp.mean(jnp.square(xf - mu), -1, keepdims=True)
    return ((xf - mu) * lax.rsqrt(var + LN_EPS) * g + b).astype(x.dtype)


def dilated_branch_prompt(q, k, v, window, dil, slopes):
    bsz, seq, nh, hd = q.shape
    nw = window // dil
    qb = nw
    sub = seq // dil
    nb = -(-sub // qb)
    lp = nb * qb

    def strided(t):
        t = t.reshape(bsz, sub, dil, nh, hd).transpose(0, 2, 1, 3, 4)
        return jnp.pad(t, ((0, 0), (0, 0), (0, lp - sub), (0, 0), (0, 0)))

    def band(t):
        prev = jnp.pad(t, ((0, 0), (0, 0), (qb, 0), (0, 0), (0, 0)))[:, :, :lp]
        return jnp.concatenate([prev.reshape(bsz, dil, nb, qb, nh, hd),
                                t.reshape(bsz, dil, nb, qb, nh, hd)], axis=3)

    qs, ks, vs = strided(q), strided(k), strided(v)
    qblk = qs.reshape(bsz, dil, nb, qb, nh, hd)
    kblk, vblk = band(ks), band(vs)
    scores = jnp.einsum('brnqhd,brnkhd->brnhqk', qblk, kblk).astype(jnp.float32) * (hd ** -0.5)
    dist = np.arange(qb)[:, None] - np.arange(2 * qb)[None, :] + qb
    key_sub = np.arange(nb)[:, None] * qb - qb + np.arange(2 * qb)[None, :]
    valid = ((dist >= 0) & (dist <= nw))[None] & (key_sub >= 0)[:, None, :]
    bias = -slopes[:, None, None] * (dist * dil).astype(np.float32)[None]
    scores = jnp.where(valid[None, None, :, None], scores + bias[None, None, None], -jnp.inf)
    m = jnp.max(scores, -1)
    e = jnp.exp(scores - m[..., None])
    s = jnp.sum(e, -1)
    acc = jnp.einsum('brnhqk,brnkhd->brnqhd', e, vblk.astype(jnp.float32))

    def unstride(t):
        t = t.reshape((bsz, dil, lp) + t.shape[4:])[:, :, :sub]
        t = jnp.moveaxis(t, 1, 2)
        return t.reshape((bsz, seq) + t.shape[3:])

    return unstride(acc), unstride(jnp.swapaxes(m, -1, -2)), unstride(jnp.swapaxes(s, -1, -2))


def dilated_branch_sample(q, kc, vc, window, dil, slopes, w_buf):
    t_new, hd = q.shape[1], q.shape[3]
    nw = window // dil
    i = np.arange(t_new)[:, None]
    back = np.arange(nw + 1)[None, :] * dil
    idx = w_buf + i - back
    valid = (PAST_LEN + i - back >= 0) & (idx >= 0)
    idx = np.clip(idx, 0, None)
    kg = kc[:, idx]
    vg = vc[:, idx]
    scores = jnp.einsum('bthd,btkhd->bhtk', q, kg).astype(jnp.float32) * (hd ** -0.5)
    bias = -slopes[:, None, None] * back.astype(np.float32)[None]
    scores = jnp.where(valid[None, None], scores + bias[None], -jnp.inf)
    m = jnp.max(scores, -1)
    e = jnp.exp(scores - m[..., None])
    s = jnp.sum(e, -1)
    acc = jnp.einsum('bhtk,btkhd->bthd', e, vg.astype(jnp.float32))
    return acc, jnp.swapaxes(m, 1, 2), jnp.swapaxes(s, 1, 2)


def combine_dilated(branches):
    m_max = functools.reduce(jnp.maximum, [m for _, m, _ in branches])
    scaled = [s * jnp.exp(m - m_max) for _, m, s in branches]
    total = functools.reduce(jnp.add, scaled)
    outs = [(sd / total)[..., None] * (acc / s[..., None])
            for (acc, _, s), sd in zip(branches, scaled)]
    return functools.reduce(jnp.add, outs)


def dilated_attention_prompt(q, k, v, slopes):
    return combine_dilated([dilated_branch_prompt(q, k, v, w, r, slopes) for (w, r) in DILATED_PAIRS])


def dilated_attention_sample(q, k, v, cache_k_l, cache_v_l, slopes):
    w_buf = cache_k_l.shape[1]
    kc = jnp.concatenate([cache_k_l.astype(k.dtype), k], axis=1)
    vc = jnp.concatenate([cache_v_l.astype(v.dtype), v], axis=1)
    return combine_dilated([dilated_branch_sample(q, kc, vc, w, r, slopes, w_buf) for (w, r) in DILATED_PAIRS])


def causal_dwconv(xpad, w, b):
    out = lax.conv_general_dilated(xpad, w[:, None, :], window_strides=(1,), padding='VALID',
                                   dimension_numbers=('NWC', 'WIO', 'NWC'),
                                   feature_group_count=xpad.shape[-1])
    return out + b


def segsum(a):
    t = a.shape[-1]
    x = jnp.broadcast_to(a[..., :, None], a.shape + (t,))
    x = jnp.where(np.tril(np.ones((t, t), dtype=bool), -1), x, 0.0)
    xs = jnp.cumsum(x, axis=-2)
    return jnp.where(np.tril(np.ones((t, t), dtype=bool)), xs, -jnp.inf)


def ssd_scan(xdt, adt, b, c, h0):
    n, seq, nh, hp = xdt.shape
    cl = min(SSD_CHUNK, seq)
    nc = -(-seq // cl)
    pad = nc * cl - seq
    padl = lambda t: jnp.pad(t, ((0, 0), (0, pad)) + ((0, 0),) * (t.ndim - 2))
    x = padl(xdt).reshape(n, nc, cl, nh, hp)
    a = padl(adt).reshape(n, nc, cl, nh).transpose(0, 3, 1, 2)
    bb = padl(b).reshape(n, nc, cl, nh, -1)
    cc = padl(c).reshape(n, nc, cl, nh, -1)
    a_cs = jnp.cumsum(a, axis=-1)
    lmat = jnp.exp(segsum(a))
    y_diag = jnp.einsum('bclhn,bcshn,bhcls,bcshp->bclhp', cc, bb, lmat, x)
    decay_states = jnp.exp(a_cs[..., -1:] - a_cs)
    states = jnp.einsum('bclhn,bhcl,bclhp->bchpn', bb, decay_states, x)
    states = jnp.concatenate([h0[:, None], states], axis=1)
    decay_chunk = jnp.exp(segsum(jnp.pad(a_cs[..., -1], ((0, 0), (0, 0), (1, 0)))))
    new_states = jnp.einsum('bhzc,bchpn->bzhpn', decay_chunk, states)
    states, h_final = new_states[:, :-1], new_states[:, -1]
    y_off = jnp.einsum('bclhn,bchpn,bhcl->bclhp', cc, states, jnp.exp(a_cs))
    y = (y_diag + y_off).reshape(n, nc * cl, nh, hp)[:, :seq]
    return y, h_final


def ssd_mixer(z, xbc, dt, conv_prev, h0, conv_w, conv_b, dt_bias, a_log, d_skip, norm_w):
    n, seq, _ = xbc.shape
    xpad = jnp.concatenate([conv_prev.astype(xbc.dtype), xbc], axis=1)
    conv_new = xpad[:, -(CONV_W - 1):]
    xbc_c = jax.nn.silu(causal_dwconv(xpad, conv_w, conv_b)).astype(jnp.float32)
    xs = xbc_c[..., :D_SSD].reshape(n, seq, N_SSD_HEADS, HEAD_DIM)
    bs = xbc_c[..., D_SSD:D_SSD + SSD_GROUPS * D_STATE].reshape(n, seq, SSD_GROUPS, D_STATE)
    cs = xbc_c[..., D_SSD + SSD_GROUPS * D_STATE:].reshape(n, seq, SSD_GROUPS, D_STATE)
    bs = jnp.repeat(bs, HEADS_PER_GROUP, axis=2)
    cs = jnp.repeat(cs, HEADS_PER_GROUP, axis=2)
    dt = jax.nn.softplus(dt.astype(jnp.float32) + dt_bias)
    a = -jnp.exp(a_log.astype(jnp.float32))
    y, h_new = ssd_scan(xs * dt[..., None], dt * a, bs, cs, h0.astype(jnp.float32))
    y = y + d_skip[:, None] * xs
    y = y.reshape(n, seq, D_SSD) * jax.nn.silu(z.astype(jnp.float32))
    yg = y.reshape(n, seq, SSD_GROUPS, D_SSD // SSD_GROUPS)
    yg = yg * lax.rsqrt(jnp.mean(jnp.square(yg), -1, keepdims=True) + LN_EPS)
    y = yg.reshape(n, seq, D_SSD) * norm_w
    return y.astype(z.dtype), conv_new, h_new.astype(h0.dtype)


def trunk_layer(x, pe, attend, conv_prev, ssm_prev, lw):
    (w_in, conv_w, conv_b, dt_bias, a_log, d_skip, ssd_norm_w, w_out,
     ln1_g, ln1_b, w_up, w_down, ln2_g, ln2_b, w_gate, w_ple, ln3_g, ln3_b) = lw
    n, seq, _ = x.shape
    proj = x @ w_in
    q, k, v, z, xbc, dt = jnp.split(proj, IN_SPLITS, axis=-1)
    heads = lambda t: t.reshape(n, seq, N_ATTN_HEADS, HEAD_DIM)
    q, k, v = heads(q), heads(k), heads(v)
    attn = attend(q, k, v).reshape(n, seq, D_ATTN).astype(x.dtype)
    ssd, conv_new, ssm_new = ssd_mixer(z, xbc, dt, conv_prev, ssm_prev, conv_w, conv_b,
                                       dt_bias, a_log, d_skip, ssd_norm_w)
    mix = jnp.concatenate([attn, ssd], axis=-1) @ w_out
    h = layer_norm(DEEPNORM_ALPHA * x + mix, ln1_g, ln1_b)
    u = jnp.square(jax.nn.relu(h @ w_up)) @ w_down
    h = layer_norm(DEEPNORM_ALPHA * h + u, ln2_g, ln2_b)
    g = jax.nn.sigmoid(h @ w_gate) * (pe @ w_ple)
    h = layer_norm(DEEPNORM_ALPHA * h + g, ln3_g, ln3_b)
    return h, k, v, conv_new, ssm_new


def setup_inputs(seed: int = 0) -> dict:
    key = jax.random.key(seed)
    ks = jax.random.split(key, 32)
    f32 = jnp.float32
    nrm = lambda kk, shape, scale: scale * jax.random.normal(kk, shape, f32)
    w_buf = min(MAX_WINDOW, PAST_LEN)
    dt0 = jnp.exp(jax.random.uniform(ks[8], (DEPTH, N_SSD_HEADS), f32, math.log(1e-3), math.log(1e-1)))
    return {
        "x_prompt": nrm(ks[0], (BATCH, SEQ, D_MODEL), 1.0),
        "x_sample": nrm(ks[1], (DEC_BATCH, DEC_SEQ, D_MODEL), 1.0),
        "cache_k": nrm(ks[2], (DEPTH, DEC_BATCH, w_buf, N_ATTN_HEADS, HEAD_DIM), 1.0),
        "cache_v": nrm(ks[3], (DEPTH, DEC_BATCH, w_buf, N_ATTN_HEADS, HEAD_DIM), 1.0),
        "state_conv": nrm(ks[4], (DEPTH, DEC_BATCH, CONV_W - 1, CONV_DIM), 1.0),
        "state_ssm": nrm(ks[5], (DEPTH, DEC_BATCH, N_SSD_HEADS, HEAD_DIM, D_STATE), 0.2),
        "p_prompt": nrm(ks[6], (DEPTH, BATCH, SEQ, D_PLE), 1.0),
        "p_sample": nrm(ks[7], (DEPTH, DEC_BATCH, DEC_SEQ, D_PLE), 1.0),
        "ln_in_g": 1.0 + nrm(ks[9], (D_MODEL,), 0.1),
        "ln_in_b": nrm(ks[10], (D_MODEL,), 0.02),
        "w_in": nrm(ks[11], (DEPTH, D_MODEL, D_IN_PROJ), D_MODEL ** -0.5),
        "conv_w": nrm(ks[12], (DEPTH, CONV_W, CONV_DIM), CONV_W ** -0.5),
        "conv_b": nrm(ks[13], (DEPTH, CONV_DIM), 0.02),
        "dt_bias": dt0 + jnp.log(-jnp.expm1(-dt0)),
        "a_log": jnp.log(jax.random.uniform(ks[14], (DEPTH, N_SSD_HEADS), f32, 1.0, 16.0)),
        "d_skip": 1.0 + nrm(ks[15], (DEPTH, N_SSD_HEADS), 0.1),
        "ssd_norm_w": 1.0 + nrm(ks[16], (DEPTH, D_SSD), 0.1),
        "w_out": nrm(ks[17], (DEPTH, D_MIX, D_MODEL), D_MIX ** -0.5 * DEEPNORM_BETA),
        "ln1_g": 1.0 + nrm(ks[18], (DEPTH, D_MODEL), 0.1),
        "ln1_b": nrm(ks[19], (DEPTH, D_MODEL), 0.02),
        "w_up": nrm(ks[20], (DEPTH, D_MODEL, D_FF), D_MODEL ** -0.5),
        "w_down": nrm(ks[21], (DEPTH, D_FF, D_MODEL), D_FF ** -0.5 * DEEPNORM_BETA),
        "ln2_g": 1.0 + nrm(ks[22], (DEPTH, D_MODEL), 0.1),
        "ln2_b": nrm(ks[23], (DEPTH, D_MODEL), 0.02),
        "w_gate": nrm(ks[24], (DEPTH, D_MODEL, D_MODEL), D_MODEL ** -0.5),
        "w_ple": nrm(ks[25], (DEPTH, D_PLE, D_MODEL), D_PLE ** -0.5 * DEEPNORM_BETA),
        "ln3_g": 1.0 + nrm(ks[26], (DEPTH, D_MODEL), 0.1),
        "ln3_b": nrm(ks[27], (DEPTH, D_MODEL), 0.02),
    }


def reference(x_prompt, x_sample, cache_k, cache_v, state_conv, state_ssm, p_prompt, p_sample,
              ln_in_g, ln_in_b, w_in, conv_w, conv_b, dt_bias, a_log, d_skip, ssd_norm_w, w_out,
              ln1_g, ln1_b, w_up, w_down, ln2_g, ln2_b, w_gate, w_ple, ln3_g, ln3_b):
    slopes = alibi_slopes(N_ATTN_HEADS)
    hp = layer_norm(x_prompt, ln_in_g, ln_in_b)
    hs = layer_norm(x_sample, ln_in_g, ln_in_b)
    kp_l, vp_l, ks_l, vs_l, cp_l, cs_l, sp_l, ss_l = [], [], [], [], [], [], [], []
    attend_prompt = functools.partial(dilated_attention_prompt, slopes=slopes)
    for i in range(DEPTH):
        lw = (w_in[i], conv_w[i], conv_b[i], dt_bias[i], a_log[i], d_skip[i], ssd_norm_w[i], w_out[i],
              ln1_g[i], ln1_b[i], w_up[i], w_down[i], ln2_g[i], ln2_b[i], w_gate[i], w_ple[i],
              ln3_g[i], ln3_b[i])
        nbp = hp.shape[0]
        conv0 = jnp.zeros((nbp, CONV_W - 1, CONV_DIM), hp.dtype)
        ssm0 = jnp.zeros((nbp, N_SSD_HEADS, HEAD_DIM, D_STATE), hp.dtype)
        hp, kp, vp, cp, sp = trunk_layer(hp, p_prompt[i], attend_prompt, conv0, ssm0, lw)
        attend_sample = functools.partial(dilated_attention_sample, cache_k_l=cache_k[i],
                                          cache_v_l=cache_v[i], slopes=slopes)
        hs, kn, vn, cn, sn = trunk_layer(hs, p_sample[i], attend_sample, state_conv[i], state_ssm[i], lw)
        keep = min(MAX_WINDOW, kp.shape[1])
        kp_l.append(kp[:, -keep:])
        vp_l.append(vp[:, -keep:])
        ks_l.append(kn)
        vs_l.append(vn)
        cp_l.append(cp)
        cs_l.append(cn)
        sp_l.append(sp)
        ss_l.append(sn)
    new_k_prompt = jnp.stack(kp_l)
    new_v_prompt = jnp.stack(vp_l)
    new_k_sample = jnp.stack(ks_l)
    new_v_sample = jnp.stack(vs_l)
    new_conv_prompt = jnp.stack(cp_l)
    new_conv_sample = jnp.stack(cs_l)
    new_ssm_prompt = jnp.stack(sp_l)
    new_ssm_sample = jnp.stack(ss_l)
    return (hp, hs, new_k_prompt, new_v_prompt, new_k_sample, new_v_sample,
            new_conv_prompt, new_conv_sample, new_ssm_prompt, new_ssm_sample)
```

```cpp
#include <hip/hip_runtime.h>
#include <cstdio>
#include <cstdint>
namespace pg8 {
#define PG8_LAS __attribute__((address_space(3)))
typedef unsigned short bf16_t;
typedef short bf16x8 __attribute__((ext_vector_type(8)));
typedef float f32x4 __attribute__((ext_vector_type(4)));
typedef unsigned u32x4 __attribute__((ext_vector_type(4)));
constexpr int BM = 256, BK = 64, HALF = 128, HTB = HALF * BK * 2  , STAGE_BYTES = 8 * HTB, NXCD = 8, WGM = 8;

__host__ __device__ __forceinline__ int lds_byte(int r, int c) { const int st = (r >> 4) * 2 + (c >> 5), rr = r & 15, cc = c & 31, ob = rr * 64 + cc * 2; return st * 1024 + (ob ^ (((ob >> 9) & 1) << 5)); }
__host__ __device__ __forceinline__ void stage_rc(int b, int& R, int& C) { const int st = b / 1024, sb = b % 1024, swz = sb ^ (((sb >> 9) & 1) << 5); R = (st >> 1) * 16 + swz / 64; C = (st & 1) * 32 + (swz % 64) / 2; }
__host__ __device__ __forceinline__ int perm32(int rho) { const int n = rho >> 4, i = rho & 15; return 8 * (i >> 2) + 4 * n + (i & 3); }

struct Unit { int pm, pn; };
struct Gemm { const bf16_t* A; const bf16_t* Bt; int M, N, K; };

struct StaticOrder {
    int nM, nN, nwg, G, c;
    __host__ __device__ void init(int M, int N, int G_, int c_) { nM = M / BM; nN = N / BM; nwg = nM * nN; G = G_; c = c_; }
    __host__ __device__ bool next(int i, Unit& u) const {
        const long L = (long)i * G + c; if (L >= nwg) return false;
        int wgid = (int)L; { const int q = nwg / NXCD, r = nwg % NXCD, xcd = wgid % NXCD, off = wgid / NXCD; wgid = (xcd < r ? xcd * (q + 1) : r * (q + 1) + (xcd - r) * q) + off; }
        const int nig = WGM * nN, gid = wgid / nig, fm = gid * WGM, gsz = (nM - fm) < WGM ? (nM - fm) : WGM;
        u.pm = fm + ((wgid % nig) % gsz); u.pn = (wgid % nig) / gsz; return true;
    }
    __device__ __forceinline__ void a_ready(const Unit&) const {}
    __device__ __forceinline__ void done(const Unit&) const {}
};
__device__ __forceinline__ unsigned cvt_pk_bf16(float lo, float hi) { unsigned r; asm volatile("v_cvt_pk_bf16_f32 %0, %1, %2" : "=v"(r) : "v"(lo), "v"(hi)); return r; }
typedef float f32x2 __attribute__((ext_vector_type(2)));
template <class Epi, class Sched, bool ALIGN_EPI = false, bool SP2 = false>
__device__ __forceinline__ void gemm_phase(PG8_LAS unsigned char* lds, const Gemm g, const Sched& S, const Epi& E) {
    const int tid = threadIdx.x, wid = __builtin_amdgcn_readfirstlane(tid >> 6), lane = tid & 63, wr = wid >> 2, wc = wid & 3, fr = lane & 15, fq = lane >> 4;
    const int K = g.K, nt = K / BK;
    unsigned voffA[2], voffB[2];
#pragma unroll
    for (int i = 0; i < 2; ++i) { int R, C; stage_rc(tid * 16 + i * 8192, R, C); const int Rb = Epi::PERM ? ((R & ~31) + perm32(R & 31)) : R;
        voffA[i] = (unsigned)(R * K + C) * 2u; voffB[i] = (unsigned)(Rb * K + C) * 2u; }
    const size_t kstep = (size_t)(BK * 2);
    const size_t hstep = (size_t)HALF * K * 2;
    const size_t tstep = 2 * hstep;
    const unsigned ldsw = (unsigned)wid * 1024u;
    const int aoff = lds_byte(wr * 64 + fr, fq * 8), boff = lds_byte(wc * 32 + fr, fq * 8);
#define PG8_SA(b, h) (((b) * 2 + (h)) * HTB)
#define PG8_SB(b, h) ((4 + (b) * 2 + (h)) * HTB)
#define PG8_STAGE(bufoff, gbase, voff) do { _Pragma("unroll") for (int _i = 0; _i < 2; ++_i) \
        __builtin_amdgcn_global_load_lds((const unsigned*)((const char*)(gbase) + (voff)[_i]), (PG8_LAS unsigned*)(lds + (bufoff) + ldsw + _i * 8192), 16, 0, 0); } while (0)
#define PG8_LDA(dst, b, h) do { _Pragma("unroll") for (int m = 0; m < 4; ++m) _Pragma("unroll") for (int k = 0; k < 2; ++k) dst[m][k] = *(const PG8_LAS bf16x8*)(lds + PG8_SA(b, h) + aoff + m * 2048 + k * 1024); } while (0)
#define PG8_LDB(dst, b, h) do { _Pragma("unroll") for (int n = 0; n < 2; ++n) _Pragma("unroll") for (int k = 0; k < 2; ++k) dst[n][k] = *(const PG8_LAS bf16x8*)(lds + PG8_SB(b, h) + boff + n * 2048 + k * 1024); } while (0)
#define PG8_MMA(ai, bj, At, Bt) do { __builtin_amdgcn_s_setprio(1); _Pragma("unroll") for (int m = 0; m < 4; ++m) _Pragma("unroll") for (int n = 0; n < 2; ++n) _Pragma("unroll") for (int k = 0; k < 2; ++k) \
        acc[ai][bj][m][n] = __builtin_amdgcn_mfma_f32_16x16x32_bf16(Bt[n][k], At[m][k], acc[ai][bj][m][n], 0, 0, 0); __builtin_amdgcn_s_setprio(0); } while (0)
#define PG8_WAIT_V(n) asm volatile("s_waitcnt vmcnt(" #n ")" ::: "memory")
#define PG8_WAIT_L(n) asm volatile("s_waitcnt lgkmcnt(" #n ")" ::: "memory")
#define PG8_BAR __builtin_amdgcn_s_barrier()
#define PG8_SCHED __builtin_amdgcn_sched_barrier(0)
    Unit cur, nxt; int ui = 0;
    if (!S.next(0, cur)) return;
    f32x4 acc[2][2][4][2];
#pragma unroll
    for (int a = 0; a < 2; ++a)
#pragma unroll
        for (int b = 0; b < 2; ++b)
#pragma unroll
            for (int m = 0; m < 4; ++m)
#pragma unroll
                for (int n = 0; n < 2; ++n) acc[a][b][m][n] = (f32x4){0.f, 0.f, 0.f, 0.f};
    bf16x8 At[4][2], B0[2][2], B1[2][2];
    const char* cA = (const char*)g.A + (size_t)cur.pm * tstep; const char* cB = (const char*)g.Bt + (size_t)cur.pn * tstep;
    S.a_ready(cur);
    if constexpr (SP2) {
        PG8_STAGE(PG8_SB(0, 0), cB, voffB); PG8_STAGE(PG8_SB(0, 1), cB + hstep, voffB); PG8_STAGE(PG8_SA(0, 0), cA, voffA); PG8_STAGE(PG8_SA(0, 1), cA + hstep, voffA);
        if (wr == 1) PG8_BAR;
        PG8_WAIT_V(2); PG8_BAR;
        PG8_STAGE(PG8_SB(1, 0), cB + kstep, voffB); PG8_STAGE(PG8_SA(1, 0), cA + kstep, voffA); PG8_STAGE(PG8_SB(1, 1), cB + hstep + kstep, voffB);
        PG8_WAIT_V(6); PG8_BAR;
    } else {
        PG8_STAGE(PG8_SB(0, 0), cB, voffB); PG8_STAGE(PG8_SA(0, 0), cA, voffA); PG8_STAGE(PG8_SB(0, 1), cB + hstep, voffB); PG8_STAGE(PG8_SA(0, 1), cA + hstep, voffA);
        if (wr == 1) PG8_BAR;
        PG8_WAIT_V(4); PG8_BAR;
        PG8_STAGE(PG8_SB(1, 0), cB + kstep, voffB); PG8_STAGE(PG8_SA(1, 0), cA + kstep, voffA); PG8_STAGE(PG8_SB(1, 1), cB + hstep + kstep, voffB);
        PG8_WAIT_V(6); PG8_BAR;
    }
    for (;;) {
        const bool has_next = S.next(ui + 1, nxt);
        const char* nA = has_next ? (const char*)g.A + (size_t)nxt.pm * tstep : cA; const char* nB = has_next ? (const char*)g.Bt + (size_t)nxt.pn * tstep : cB;
        for (int t = 0; t < nt; t += 2) {
            const bool last = (t == nt - 2);
            const char* a1 = cA + (size_t)(t + 1) * kstep;
            const char* a2 = last ? nA : cA + (size_t)(t + 2) * kstep; const char* b2 = last ? nB : cB + (size_t)(t + 2) * kstep;
            const char* a3 = a2 + kstep; const char* b3 = b2 + kstep;
            if (last && has_next) S.a_ready(nxt);
            if constexpr (SP2) {
            PG8_LDB(B0, 0, 0); PG8_LDB(B1, 0, 1); PG8_SCHED; PG8_LDA(At, 0, 0); PG8_STAGE(PG8_SA(1, 1), a1 + hstep, voffA);
            PG8_WAIT_V(8); PG8_WAIT_L(0); PG8_BAR; PG8_MMA(0, 0, At, B0); PG8_MMA(0, 1, At, B1); PG8_BAR; PG8_SCHED;
            PG8_LDA(At, 0, 1); PG8_STAGE(PG8_SB(0, 0), b2, voffB); PG8_STAGE(PG8_SB(0, 1), b2 + hstep, voffB); PG8_STAGE(PG8_SA(0, 0), a2, voffA);
            PG8_WAIT_V(8); PG8_WAIT_L(0); PG8_BAR; PG8_MMA(1, 0, At, B0); PG8_MMA(1, 1, At, B1); PG8_BAR; PG8_SCHED;
            PG8_LDB(B0, 1, 0); PG8_LDB(B1, 1, 1); PG8_SCHED; PG8_LDA(At, 1, 0); PG8_STAGE(PG8_SA(0, 1), a2 + hstep, voffA);
            PG8_WAIT_V(8); PG8_WAIT_L(0); PG8_BAR; PG8_MMA(0, 0, At, B0); PG8_MMA(0, 1, At, B1); PG8_BAR; PG8_SCHED;
            PG8_LDA(At, 1, 1); PG8_STAGE(PG8_SB(1, 0), b3, voffB); PG8_STAGE(PG8_SB(1, 1), b3 + hstep, voffB); PG8_STAGE(PG8_SA(1, 0), a3, voffA);
            PG8_WAIT_V(8); PG8_WAIT_L(0); PG8_BAR; PG8_MMA(1, 0, At, B0); PG8_MMA(1, 1, At, B1); PG8_BAR; PG8_SCHED;
            } else {
            PG8_LDB(B0, 0, 0); PG8_SCHED; PG8_LDA(At, 0, 0); PG8_STAGE(PG8_SA(1, 1), a1 + hstep, voffA);
            PG8_WAIT_L(8); PG8_BAR; PG8_WAIT_L(0); PG8_MMA(0, 0, At, B0); PG8_BAR; PG8_SCHED;
            PG8_LDB(B1, 0, 1); PG8_STAGE(PG8_SB(0, 0), b2, voffB);
            PG8_BAR; PG8_WAIT_L(0); PG8_MMA(0, 1, At, B1); PG8_BAR;
            PG8_LDA(At, 0, 1); PG8_STAGE(PG8_SA(0, 0), a2, voffA);
            PG8_BAR; PG8_WAIT_L(0); PG8_MMA(1, 0, At, B0); PG8_BAR; PG8_SCHED;
            PG8_STAGE(PG8_SB(0, 1), b2 + hstep, voffB);
            PG8_WAIT_V(6); PG8_BAR; PG8_MMA(1, 1, At, B1); PG8_BAR;
            PG8_LDB(B0, 1, 0); PG8_SCHED; PG8_LDA(At, 1, 0); PG8_STAGE(PG8_SA(0, 1), a2 + hstep, voffA);
            PG8_WAIT_L(8); PG8_BAR; PG8_WAIT_L(0); PG8_MMA(0, 0, At, B0); PG8_BAR; PG8_SCHED;
            PG8_LDB(B1, 1, 1); PG8_STAGE(PG8_SB(1, 0), b3, voffB);
            PG8_BAR; PG8_WAIT_L(0); PG8_MMA(0, 1, At, B1); PG8_BAR;
            PG8_LDA(At, 1, 1); PG8_STAGE(PG8_SA(1, 0), a3, voffA);
            PG8_BAR; PG8_WAIT_L(0); PG8_MMA(1, 0, At, B0); PG8_BAR; PG8_SCHED;
            PG8_STAGE(PG8_SB(1, 1), b3 + hstep, voffB);
            PG8_WAIT_V(6); PG8_BAR; PG8_MMA(1, 1, At, B1); PG8_BAR;
            }
        }
        if constexpr (ALIGN_EPI) { if (wr == 0) PG8_BAR; }
        if constexpr (!Epi::AFTER_DRAIN) { E(acc, cur, wr, wc, fr, fq); S.done(cur); }
        if (!has_next) break;
#pragma unroll
        for (int a = 0; a < 2; ++a)
#pragma unroll
            for (int b = 0; b < 2; ++b)
#pragma unroll
                for (int m = 0; m < 4; ++m)
#pragma unroll
                    for (int n = 0; n < 2; ++n) acc[a][b][m][n] = (f32x4){0.f, 0.f, 0.f, 0.f};
        cur = nxt; cA = nA; cB = nB; ++ui;
        if constexpr (ALIGN_EPI) { if (wr == 1) PG8_BAR; }
    }
    PG8_WAIT_V(0);
    if constexpr (!ALIGN_EPI) { if (wr == 0) PG8_BAR; }
    PG8_BAR;
    if constexpr (Epi::AFTER_DRAIN) { E.fused(acc, cur, wr, wc, fr, fq, lds, wid, lane); S.done(cur); }
#undef PG8_SA
#undef PG8_SB
#undef PG8_STAGE
#undef PG8_LDA
#undef PG8_LDB
#undef PG8_MMA
#undef PG8_WAIT_V
#undef PG8_WAIT_L
#undef PG8_BAR
#undef PG8_SCHED
}
}
constexpr int DM = 1024, NBATCH = 8, SEQ = 2048, MP = NBATCH * SEQ, DECB = 128, DECT = 8, MS = DECB * DECT, M = MP + MS;
constexpr int NPROJ = 3072, NINP = 3080, HD = 64, NH = 8, DST = 128, DFF = 4096, DPLE = 256, CONVD = 1024, WBUF = 2048;
constexpr int CQ = 0, CK = 512, CV = 1024, CZ = 1536, CXB = 2048;
constexpr float LN_EPS = 1e-5f, ALPHA = 1.189207115002721f, LOG2E = 1.4426950408889634f;
constexpr size_t O_Y = 0, O_KP = 17825792, O_VP = 26214400, O_KS = 34603008, O_VS = 35127296, O_CP = 35651584, O_CS = 35676160, O_SP = 36069376, O_SS = 36593664, O_END = 44982272;
constexpr size_t MiB = 1u << 20;
constexpr size_t WS_CTL = 0, CTL_ZERO_BYTES = 1 * MiB;
constexpr size_t WS_ST1 = 65536, WS_ST2 = 262144, WS_CSUP = 524288, WS_BWUP = 540672, WS_CSG = 557056, WS_BWG = 561152;
constexpr size_t WS_WIN = 2 * MiB, WS_WOUT = 8 * MiB, WS_WUP = 10 * MiB, WS_WDOWN = 18 * MiB, WS_WGATE = 26 * MiB, WS_WPLE = 28 * MiB;
constexpr size_t WS_DT = 29 * MiB, WS_ATOT = 30 * MiB, WS_H0 = 32 * MiB, WS_PE = 66 * MiB, WS_PROJ = 76 * MiB, WS_MIX = 178 * MiB, WS_V1 = 212 * MiB, WS_V2 = 246 * MiB;
constexpr size_t WS_PLE = 280 * MiB, WS_STLOC = 314 * MiB, WS_U = 346 * MiB, WS_END = 482 * MiB;
constexpr int CW_TMO = 0, CW_BAR = 4096;
constexpr int RING_BYTES = 151552;
constexpr int LDSCTL_OFF = RING_BYTES, MISC_OFF = LDSCTL_OFF + 320;
constexpr int LDS_BYTES = 155648;
constexpr int NWAVES = 8;

#define GAS __attribute__((address_space(1)))
#define LAS __attribute__((address_space(3)))
typedef unsigned short bf16;
typedef unsigned v4u __attribute__((ext_vector_type(4)));
typedef unsigned v2u __attribute__((ext_vector_type(2)));
typedef float f32x4 __attribute__((ext_vector_type(4)));
typedef float f32x16 __attribute__((ext_vector_type(16)));
typedef short bf16x8 __attribute__((ext_vector_type(8)));
typedef short s16x4 __attribute__((ext_vector_type(4)));
typedef GAS unsigned gu32;
#define RLX_AGENT __ATOMIC_RELAXED, __HIP_MEMORY_SCOPE_AGENT
#define LDS_WAIT() asm volatile("s_waitcnt lgkmcnt(0)" ::: "memory")
#define VM_WAIT() asm volatile("s_waitcnt vmcnt(0)" ::: "memory")
__device__ __forceinline__ unsigned f2bf(float f) { unsigned u = __builtin_bit_cast(unsigned, f); return (u + 0x7fffu + ((u >> 16) & 1u)) >> 16; }
typedef float f32x2_t __attribute__((ext_vector_type(2))); typedef __bf16 bf16x2_t __attribute__((ext_vector_type(2)));
__device__ __forceinline__ unsigned pk2(float lo, float hi) { f32x2_t v = {lo, hi}; bf16x2_t b = __builtin_convertvector(v, bf16x2_t); return __builtin_bit_cast(unsigned, b); }
__device__ __forceinline__ float bf2f(unsigned short h) { return __builtin_bit_cast(float, (unsigned)h << 16); }
__device__ __forceinline__ float bflo(unsigned w) { return __builtin_bit_cast(float, w << 16); }
__device__ __forceinline__ float bfhi(unsigned w) { return __builtin_bit_cast(float, w & 0xffff0000u); }
__device__ __forceinline__ float fast_exp2(float x) { return __builtin_amdgcn_exp2f(x); }
__device__ __forceinline__ float fast_exp(float x) { return __builtin_amdgcn_exp2f(x * LOG2E); }
__device__ __forceinline__ float sigmoidf_(float x) { return 1.0f / (1.0f + fast_exp(-x)); }
__device__ __forceinline__ float siluf_(float x) { return x * sigmoidf_(x); }
__device__ __forceinline__ int crow(int r, int hi) { return (r & 3) + 8 * (r >> 2) + 4 * hi; }
__device__ __forceinline__ float wave_sum(float v) {
#pragma unroll
    for (int o = 1; o < 64; o <<= 1) v += __shfl_xor(v, o);
    return v;
}
__device__ __forceinline__ bf16x8 pack8(float a0, float a1, float a2, float a3, float a4, float a5, float a6, float a7) {
    v4u w; w.x = pk2(a0, a1); w.y = pk2(a2, a3); w.z = pk2(a4, a5); w.w = pk2(a6, a7); return __builtin_bit_cast(bf16x8, w);
}
__device__ __forceinline__ bf16x8 cvt8(f32x4 a, f32x4 b) { return pack8(a[0], a[1], a[2], a[3], b[0], b[1], b[2], b[3]); }
#define EPI_ARGS const pg8::f32x4 (&acc)[2][2][4][2], const pg8::Unit& u, int wr, int wc, int fr, int fq
__device__ __forceinline__ v4u pack_acc8(const f32x4 a, const f32x4 b) { v4u w; w.x = pk2(a[0], a[1]); w.y = pk2(a[2], a[3]); w.z = pk2(b[0], b[1]); w.w = pk2(b[2], b[3]); return w; }
__device__ __forceinline__ void row_stats(float mu_s, float s2, float& mu, float& rs) { mu = mu_s * (1.0f / DM); const float var = s2 * (1.0f / DM) - mu * mu; rs = 1.0f / sqrtf(fmaxf(var, 0.f) + LN_EPS); }

struct EpiProj {
    static constexpr bool PERM = true, AFTER_DRAIN = false;
    bf16* P; float* out;
    __device__ __forceinline__ void operator()(EPI_ARGS) const {
        const int pn = u.pn; const bool kv = (pn >= 2 && pn < 6); const bool isv = pn >= 4; const bool prompt = u.pm < (MP / 256);
        const int col0 = pn * 256 + wc * 32 + 8 * fq; const int row0 = u.pm * 256 + wr * 64 + fr;
        float* ob = out + (prompt ? (isv ? O_VP : O_KP) : (isv ? O_VS : O_KS)); const int rsub = prompt ? 0 : MP; const int csub = isv ? CV : CK;
#pragma unroll
        for (int ai = 0; ai < 2; ++ai)
#pragma unroll
            for (int m = 0; m < 4; ++m) { const int row = row0 + ai * 128 + m * 16;
#pragma unroll
                for (int bj = 0; bj < 2; ++bj) { const int col = col0 + bj * 128;
                    *(v4u*)(P + (size_t)row * NPROJ + col) = pack_acc8(acc[ai][bj][m][0], acc[ai][bj][m][1]);
                    if (kv) { float* o = ob + (size_t)(row - rsub) * 512 + (col - csub); *(f32x4*)o = acc[ai][bj][m][0]; *(f32x4*)(o + 4) = acc[ai][bj][m][1]; } } }
    }
};
struct EpiOut {
    static constexpr bool PERM = true, AFTER_DRAIN = false;
    const bf16* H0; bf16* V1; float* ST;
    __device__ __forceinline__ void operator()(EPI_ARGS) const {
        const int col0 = u.pn * 256 + wc * 32 + 8 * fq; const int row0 = u.pm * 256 + wr * 64 + fr;
#pragma unroll
        for (int ai = 0; ai < 2; ++ai)
#pragma unroll
            for (int m = 0; m < 4; ++m) { const int row = row0 + ai * 128 + m * 16; float s = 0.f, s2 = 0.f;
#pragma unroll
                for (int bj = 0; bj < 2; ++bj) { const int col = col0 + bj * 128; const size_t off = (size_t)row * DM + col;
                    const v4u hw = *(const v4u*)(H0 + off); f32x4 a = acc[ai][bj][m][0], b = acc[ai][bj][m][1];
                    a[0] += ALPHA * bflo(hw.x); a[1] += ALPHA * bfhi(hw.x); a[2] += ALPHA * bflo(hw.y); a[3] += ALPHA * bfhi(hw.y);
                    b[0] += ALPHA * bflo(hw.z); b[1] += ALPHA * bfhi(hw.z); b[2] += ALPHA * bflo(hw.w); b[3] += ALPHA * bfhi(hw.w);
                    s += (a[0] + a[1]) + (a[2] + a[3]) + (b[0] + b[1]) + (b[2] + b[3]);
                    s2 += (a[0] * a[0] + a[1] * a[1]) + (a[2] * a[2] + a[3] * a[3]) + (b[0] * b[0] + b[1] * b[1]) + (b[2] * b[2] + b[3] * b[3]);
                    *(v4u*)(V1 + off) = pack_acc8(a, b); }
                s += __shfl_xor(s, 16); s += __shfl_xor(s, 32); s2 += __shfl_xor(s2, 16); s2 += __shfl_xor(s2, 32);
                if (fq == 0) { unsafeAtomicAdd(ST + 2 * row, s); unsafeAtomicAdd(ST + 2 * row + 1, s2); } }
    }
};
struct EpiUp {
    static constexpr bool PERM = true, AFTER_DRAIN = false;
    bf16* U; const float* ST; const float* cs; const float* bw;
    __device__ __forceinline__ void operator()(EPI_ARGS) const {
        const int col0 = u.pn * 256 + wc * 32 + 8 * fq; const int row0 = u.pm * 256 + wr * 64 + fr;
#pragma unroll
        for (int bj = 0; bj < 2; ++bj) { const int col = col0 + bj * 128;
            const f32x4 c0 = *(const f32x4*)(cs + col), c1 = *(const f32x4*)(cs + col + 4), w0 = *(const f32x4*)(bw + col), w1 = *(const f32x4*)(bw + col + 4);
#pragma unroll
            for (int ai = 0; ai < 2; ++ai)
#pragma unroll
                for (int m = 0; m < 4; ++m) { const int row = row0 + ai * 128 + m * 16; float mu, rs; row_stats(ST[2 * row], ST[2 * row + 1], mu, rs);
                    f32x4 a = (acc[ai][bj][m][0] - mu * c0) * rs + w0, b = (acc[ai][bj][m][1] - mu * c1) * rs + w1;
#pragma unroll
                    for (int k = 0; k < 4; ++k) { a[k] = fmaxf(a[k], 0.f); a[k] *= a[k]; b[k] = fmaxf(b[k], 0.f); b[k] *= b[k]; }
                    *(v4u*)(U + (size_t)row * DFF + col) = pack_acc8(a, b); } }
    }
};
struct EpiDown {
    static constexpr bool PERM = true, AFTER_DRAIN = false;
    const bf16* V1; bf16* V2; const float* ST1; float* ST2; const float* g; const float* bb;
    __device__ __forceinline__ void operator()(EPI_ARGS) const {
        const int col0 = u.pn * 256 + wc * 32 + 8 * fq; const int row0 = u.pm * 256 + wr * 64 + fr;
        float ss[2][4], ss2[2][4];
#pragma unroll
        for (int ai = 0; ai < 2; ++ai)
#pragma unroll
            for (int m = 0; m < 4; ++m) { ss[ai][m] = 0.f; ss2[ai][m] = 0.f; }
#pragma unroll
        for (int bj = 0; bj < 2; ++bj) { const int col = col0 + bj * 128;
            const f32x4 g0 = *(const f32x4*)(g + col), g1 = *(const f32x4*)(g + col + 4), b0 = *(const f32x4*)(bb + col), b1 = *(const f32x4*)(bb + col + 4);
#pragma unroll
            for (int ai = 0; ai < 2; ++ai)
#pragma unroll
                for (int m = 0; m < 4; ++m) { const int row = row0 + ai * 128 + m * 16; float mu, rs; row_stats(ST1[2 * row], ST1[2 * row + 1], mu, rs);
                    const size_t off = (size_t)row * DM + col; const v4u hw = *(const v4u*)(V1 + off);
                    f32x4 x0 = {bflo(hw.x), bfhi(hw.x), bflo(hw.y), bfhi(hw.y)}, x1 = {bflo(hw.z), bfhi(hw.z), bflo(hw.w), bfhi(hw.w)};
                    const f32x4 a = acc[ai][bj][m][0] + ALPHA * ((x0 - mu) * rs * g0 + b0), b = acc[ai][bj][m][1] + ALPHA * ((x1 - mu) * rs * g1 + b1);
                    ss[ai][m] += (a[0] + a[1]) + (a[2] + a[3]) + (b[0] + b[1]) + (b[2] + b[3]);
                    ss2[ai][m] += (a[0] * a[0] + a[1] * a[1]) + (a[2] * a[2] + a[3] * a[3]) + (b[0] * b[0] + b[1] * b[1]) + (b[2] * b[2] + b[3] * b[3]);
                    *(v4u*)(V2 + off) = pack_acc8(a, b); } }
#pragma unroll
        for (int ai = 0; ai < 2; ++ai)
#pragma unroll
            for (int m = 0; m < 4; ++m) { const int row = row0 + ai * 128 + m * 16; float s = ss[ai][m], s2 = ss2[ai][m];
                s += __shfl_xor(s, 16); s += __shfl_xor(s, 32); s2 += __shfl_xor(s2, 16); s2 += __shfl_xor(s2, 32);
                if (fq == 0) { unsafeAtomicAdd(ST2 + 2 * row, s); unsafeAtomicAdd(ST2 + 2 * row + 1, s2); } }
    }
};
struct EpiPle {
    static constexpr bool PERM = true, AFTER_DRAIN = false;
    bf16* O;
    __device__ __forceinline__ void operator()(EPI_ARGS) const {
        const int col0 = u.pn * 256 + wc * 32 + 8 * fq; const int row0 = u.pm * 256 + wr * 64 + fr;
#pragma unroll
        for (int ai = 0; ai < 2; ++ai)
#pragma unroll
            for (int m = 0; m < 4; ++m)
#pragma unroll
                for (int bj = 0; bj < 2; ++bj) *(v4u*)(O + (size_t)(row0 + ai * 128 + m * 16) * DM + col0 + bj * 128) = pack_acc8(acc[ai][bj][m][0], acc[ai][bj][m][1]);
    }
};
struct EpiGate {
    static constexpr bool PERM = true, AFTER_DRAIN = false;
    const bf16* V2; const bf16* PLE; float* Y; const float* ST2; const float* cs; const float* bw; const float* g; const float* bb;
    __device__ __forceinline__ void operator()(EPI_ARGS) const {
        const int col0 = u.pn * 256 + wc * 32 + 8 * fq; const int row0 = u.pm * 256 + wr * 64 + fr;
#pragma unroll
        for (int bj = 0; bj < 2; ++bj) { const int col = col0 + bj * 128;
            const f32x4 c0 = *(const f32x4*)(cs + col), c1 = *(const f32x4*)(cs + col + 4), w0 = *(const f32x4*)(bw + col), w1 = *(const f32x4*)(bw + col + 4);
            const f32x4 g0 = *(const f32x4*)(g + col), g1 = *(const f32x4*)(g + col + 4), b0 = *(const f32x4*)(bb + col), b1 = *(const f32x4*)(bb + col + 4);
#pragma unroll
            for (int ai = 0; ai < 2; ++ai)
#pragma unroll
                for (int m = 0; m < 4; ++m) { const int row = row0 + ai * 128 + m * 16; float mu, rs; row_stats(ST2[2 * row], ST2[2 * row + 1], mu, rs);
                    const size_t off = (size_t)row * DM + col; const v4u hw = *(const v4u*)(V2 + off), pw = *(const v4u*)(PLE + off);
                    f32x4 x0 = {bflo(hw.x), bfhi(hw.x), bflo(hw.y), bfhi(hw.y)}, x1 = {bflo(hw.z), bfhi(hw.z), bflo(hw.w), bfhi(hw.w)};
                    f32x4 p0 = {bflo(pw.x), bfhi(pw.x), bflo(pw.y), bfhi(pw.y)}, p1 = {bflo(pw.z), bfhi(pw.z), bflo(pw.w), bfhi(pw.w)};
                    f32x4 ga = (acc[ai][bj][m][0] - mu * c0) * rs + w0, gb = (acc[ai][bj][m][1] - mu * c1) * rs + w1;
#pragma unroll
                    for (int k = 0; k < 4; ++k) { ga[k] = sigmoidf_(ga[k]); gb[k] = sigmoidf_(gb[k]); }
                    const f32x4 a = ALPHA * ((x0 - mu) * rs * g0 + b0) + ga * p0, b = ALPHA * ((x1 - mu) * rs * g1 + b1) + gb * p1;
                    *(f32x4*)(Y + off) = a; *(f32x4*)(Y + off + 4) = b; } }
    }
};
#define XB_TMO      128
#define XB_XCNT(j)  (256  + 64 * (j))
#define XB_XSUB(j)  (1280 + 64 * (j))
#define XB_XGEN(j)  (2304 + 64 * (j))
#define XB_TOP      3328
#define XB_TOPGEN   3392
#define XCD_BAR_WORDS 3456
#define XB_SPIN_CAP (1u << 18)

__device__ __forceinline__ unsigned xb_ld(unsigned* p)              { return __hip_atomic_load(p, __ATOMIC_RELAXED, __HIP_MEMORY_SCOPE_AGENT); }
__device__ __forceinline__ unsigned xb_add(unsigned* p, unsigned v) { return __hip_atomic_fetch_add(p, v, __ATOMIC_RELAXED, __HIP_MEMORY_SCOPE_AGENT); }
__device__ __forceinline__ unsigned xb_xcc_id() { return (unsigned)__builtin_amdgcn_s_getreg((3 << 11) | 20) & 0xFu; }
#define XB_SPIN(cond, bar) do { unsigned _sp = 0; while (cond) { __builtin_amdgcn_s_sleep(1); \
    if ((++_sp & 255u) == 0u) { if (xb_ld(&(bar)[XB_TMO])) break; if (_sp > XB_SPIN_CAP) { atomicAdd(&(bar)[XB_TMO], 1u); break; } } } } while (0)

struct XcdBarrier {
    unsigned* bar; unsigned x;
    volatile LAS unsigned* st;
};

__device__ __forceinline__ XcdBarrier xcd_barrier_post(unsigned* bar, volatile LAS unsigned* st) {
    XcdBarrier b; b.bar = bar; b.x = xb_xcc_id(); b.st = st;
    if (threadIdx.x == 0) (void)xb_add(&bar[XB_XCNT(b.x)], 1u);
    return b;
}
__device__ __forceinline__ void xcd_barrier_complete(unsigned* bar, unsigned x, unsigned& nloc, unsigned& nx) {
    const unsigned G = gridDim.x * gridDim.y * gridDim.z;
    unsigned sum, cnt, mine, sp = 0u;
    for (;;) {
        sum = 0u; cnt = 0u; mine = 0u;
#pragma unroll
        for (unsigned j = 0; j < 16; ++j) { const unsigned c = xb_ld(&bar[XB_XCNT(j)]); sum += c; cnt += (c > 0u) ? 1u : 0u; mine = (j == x) ? c : mine; }
        if (sum == G) break;
        __builtin_amdgcn_s_sleep(1);
        if ((++sp & 255u) == 0u) { if (xb_ld(&bar[XB_TMO])) break; if (sp > XB_SPIN_CAP) { atomicAdd(&bar[XB_TMO], 1u); break; } }
    }
    nloc = mine > 0u ? mine : 1u; nx = cnt > 0u ? cnt : 1u;
}

__device__ __forceinline__ void xcd_barrier(const XcdBarrier& b) {
    asm volatile("s_waitcnt vmcnt(0)" ::: "memory");
    __syncthreads();
    if (threadIdx.x == 0) {
        unsigned* bar = b.bar;
        __builtin_amdgcn_s_waitcnt(0);
        unsigned nloc = b.st[0], nx = b.st[1];
        if (nloc == 0u) { xcd_barrier_complete(bar, b.x, nloc, nx); b.st[0] = nloc; b.st[1] = nx; }
        const unsigned old = xb_add(&bar[XB_XSUB(b.x)], 1u);
        const unsigned gen = old / nloc;
        if (old + 1u == (gen + 1u) * nloc) {
            __builtin_amdgcn_fence(__ATOMIC_RELEASE, "agent");
            asm volatile("s_waitcnt vmcnt(0)" ::: "memory");
            const unsigned og = xb_add(&bar[XB_TOP], 1u);
            const unsigned tg = og / nx;
            if (og + 1u == (tg + 1u) * nx) xb_add(&bar[XB_TOPGEN], 1u);
            else XB_SPIN(xb_ld(&bar[XB_TOPGEN]) == tg, bar);
            __builtin_amdgcn_fence(__ATOMIC_ACQUIRE, "agent");
            xb_add(&bar[XB_XGEN(b.x)], 1u);
            asm volatile("s_waitcnt vmcnt(0)" ::: "memory");
        } else {
            XB_SPIN(xb_ld(&bar[XB_XGEN(b.x)]) == gen, bar);
            __builtin_amdgcn_fence(__ATOMIC_ACQUIRE, "agent");
            asm volatile("s_waitcnt vmcnt(0)" ::: "memory");
        }
    }
    __syncthreads();
}
struct Args { const float* in[28]; float* out; unsigned char* ws; int ph_lo, ph_hi; };
typedef const __attribute__((address_space(4))) Args* CArgs;
struct Frame { LAS unsigned char* lds; volatile LAS unsigned* MISC; gu32* ctl; int tid, lane, wave, vcu, G; };
enum { I_XP = 0, I_XS, I_CK, I_CV, I_SCONV, I_SSSM, I_PP, I_PS, I_LNG, I_LNB, I_WIN, I_CONVW, I_CONVB, I_DTB, I_ALOG, I_DSKIP, I_NORMW, I_WOUT, I_LN1G, I_LN1B, I_WUP, I_WDOWN, I_LN2G, I_LN2B, I_WGATE, I_WPLE, I_LN3G, I_LN3B };

template <bool FOLD>
__device__ __forceinline__ void p0_transpose_item(const float* W, int K, int N, int ldw, bf16* WT, LAS float* scr, int item, int lane, const float* g, const float* bvec, float* cs, float* bw) {
    const int nblk = N / 32, kb = item / nblk, nb = item % nblk, k0 = 64 * kb, n0 = 32 * nb;
    float csp = 0.f, bwp = 0.f;
#pragma unroll 8
    for (int i = 0; i < 32; ++i) { const int kk = 2 * i + (lane >> 5); float w = W[(size_t)(k0 + kk) * ldw + n0 + (lane & 31)];
        if (FOLD) { const float gk = g[k0 + kk], bk = bvec[k0 + kk]; bwp += w * bk; w *= gk; csp += w; }
        scr[kk * 33 + (lane & 31)] = w; }
    if (FOLD) { csp += __shfl_xor(csp, 32); bwp += __shfl_xor(bwp, 32); if (lane < 32) { unsafeAtomicAdd(cs + n0 + lane, csp); unsafeAtomicAdd(bw + n0 + lane, bwp); } }
    LDS_WAIT(); asm volatile("" ::: "memory");
    const int c = lane & 7;
#pragma unroll
    for (int j = 0; j < 4; ++j) { const int n = (lane >> 3) + 8 * j; const LAS float* s = scr + (8 * c) * 33 + n;
        v4u o; o.x = pk2(s[0 * 33], s[1 * 33]); o.y = pk2(s[2 * 33], s[3 * 33]); o.z = pk2(s[4 * 33], s[5 * 33]); o.w = pk2(s[6 * 33], s[7 * 33]);
        *(v4u*)(WT + (size_t)(n0 + n) * K + k0 + 8 * c) = o; }
    LDS_WAIT(); asm volatile("" ::: "memory");
}
__device__ __forceinline__ void p0_prologue(const Frame& F, CArgs A) {
    unsigned char* ws = A->ws;
    LAS float* scr = (LAS float*)(F.lds + F.wave * 8448);
    const int gw = F.vcu * NWAVES + F.wave, NGW = F.G * NWAVES;
    constexpr int I_IN = (DM / 64) * (NPROJ / 32), I_O = (DM / 64) * (DM / 32), I_UP = (DM / 64) * (DFF / 32), I_DN = (DFF / 64) * (DM / 32), I_G = I_O, I_PL = (DPLE / 64) * (DM / 32);
    constexpr int NITEMS = I_IN + I_O + I_UP + I_DN + I_G + I_PL;
    for (int it = gw; it < NITEMS; it += NGW) {
        int r = it;
        if (r < I_IN) { p0_transpose_item<false>(A->in[I_WIN], DM, NPROJ, NINP, (bf16*)(ws + WS_WIN), scr, r, F.lane, nullptr, nullptr, nullptr, nullptr); continue; } r -= I_IN;
        if (r < I_O) { p0_transpose_item<false>(A->in[I_WOUT], DM, DM, DM, (bf16*)(ws + WS_WOUT), scr, r, F.lane, nullptr, nullptr, nullptr, nullptr); continue; } r -= I_O;
        if (r < I_UP) { p0_transpose_item<true>(A->in[I_WUP], DM, DFF, DFF, (bf16*)(ws + WS_WUP), scr, r, F.lane, A->in[I_LN1G], A->in[I_LN1B], (float*)(ws + WS_CSUP), (float*)(ws + WS_BWUP)); continue; } r -= I_UP;
        if (r < I_DN) { p0_transpose_item<false>(A->in[I_WDOWN], DFF, DM, DM, (bf16*)(ws + WS_WDOWN), scr, r, F.lane, nullptr, nullptr, nullptr, nullptr); continue; } r -= I_DN;
        if (r < I_G) { p0_transpose_item<true>(A->in[I_WGATE], DM, DM, DM, (bf16*)(ws + WS_WGATE), scr, r, F.lane, A->in[I_LN2G], A->in[I_LN2B], (float*)(ws + WS_CSG), (float*)(ws + WS_BWG)); continue; } r -= I_G;
        p0_transpose_item<false>(A->in[I_WPLE], DPLE, DM, DM, (bf16*)(ws + WS_WPLE), scr, r, F.lane, nullptr, nullptr, nullptr, nullptr);
    }
    LAS float* wdt = (LAS float*)(F.lds + 69632);
    for (int idx = F.tid; idx < 8192; idx += NWAVES * 64) wdt[idx] = A->in[I_WIN][(size_t)(idx >> 3) * NINP + NPROJ + (idx & 7)];
    __syncthreads();
    f32x4 gv[4], bv[4];
#pragma unroll
    for (int j = 0; j < 4; ++j) { gv[j] = ((const f32x4*)A->in[I_LNG])[F.lane + 64 * j]; bv[j] = ((const f32x4*)A->in[I_LNB])[F.lane + 64 * j]; }
    bf16* H0 = (bf16*)(ws + WS_H0); bf16* PE = (bf16*)(ws + WS_PE); float* DT = (float*)(ws + WS_DT);
    for (int m = gw; m < M; m += NGW) {
        const float* xrow = m < MP ? A->in[I_XP] + (size_t)m * DM : A->in[I_XS] + (size_t)(m - MP) * DM;
        f32x4 v[4]; float s = 0.f;
#pragma unroll
        for (int j = 0; j < 4; ++j) { v[j] = ((const f32x4*)xrow)[F.lane + 64 * j]; s += (v[j][0] + v[j][1]) + (v[j][2] + v[j][3]); }
        const float mean = wave_sum(s) * (1.f / DM); float s2 = 0.f;
#pragma unroll
        for (int j = 0; j < 4; ++j) { v[j] = v[j] - mean; s2 += (v[j][0] * v[j][0] + v[j][1] * v[j][1]) + (v[j][2] * v[j][2] + v[j][3] * v[j][3]); }
        const float rstd = 1.f / sqrtf(wave_sum(s2) * (1.f / DM) + LN_EPS);
        float d[8];
#pragma unroll
        for (int q = 0; q < 8; ++q) d[q] = 0.f;
        unsigned long long* o8 = (unsigned long long*)(H0 + (size_t)m * DM) + F.lane;
#pragma unroll
        for (int j = 0; j < 4; ++j) { v[j] = v[j] * rstd * gv[j] + bv[j];
            o8[64 * j] = (unsigned long long)pk2(v[j][0], v[j][1]) | ((unsigned long long)pk2(v[j][2], v[j][3]) << 32);
#pragma unroll
            for (int e = 0; e < 4; ++e) { const LAS float* wr_ = wdt + (4 * F.lane + 256 * j + e) * 8; const f32x4 w0 = *(const LAS f32x4*)wr_, w1 = *(const LAS f32x4*)(wr_ + 4);
                d[0] += v[j][e] * w0[0]; d[1] += v[j][e] * w0[1]; d[2] += v[j][e] * w0[2]; d[3] += v[j][e] * w0[3];
                d[4] += v[j][e] * w1[0]; d[5] += v[j][e] * w1[1]; d[6] += v[j][e] * w1[2]; d[7] += v[j][e] * w1[3]; } }
#pragma unroll
        for (int q = 0; q < 8; ++q) d[q] = wave_sum(d[q]);
        if (F.lane == 0) { *(f32x4*)(DT + (size_t)m * 8) = (f32x4){d[0], d[1], d[2], d[3]}; *(f32x4*)(DT + (size_t)m * 8 + 4) = (f32x4){d[4], d[5], d[6], d[7]}; }
        const float* prow = m < MP ? A->in[I_PP] + (size_t)m * DPLE : A->in[I_PS] + (size_t)(m - MP) * DPLE;
        const f32x4 pv = ((const f32x4*)prow)[F.lane];
        ((unsigned long long*)(PE + (size_t)m * DPLE))[F.lane] = (unsigned long long)pk2(pv[0], pv[1]) | ((unsigned long long)pk2(pv[2], pv[3]) << 32);
    }
}
__device__ __forceinline__ void p9_final_ln(const Frame& F, CArgs A) {
    const int gw = F.vcu * NWAVES + F.wave, NGW = F.G * NWAVES;
    f32x4 gv[4], bv[4];
#pragma unroll
    for (int j = 0; j < 4; ++j) { gv[j] = ((const f32x4*)A->in[I_LN3G])[F.lane + 64 * j]; bv[j] = ((const f32x4*)A->in[I_LN3B])[F.lane + 64 * j]; }
    for (int m = gw; m < M; m += NGW) {
        f32x4* yrow = (f32x4*)(A->out + O_Y + (size_t)m * DM);
        f32x4 v[4]; float s = 0.f;
#pragma unroll
        for (int j = 0; j < 4; ++j) { v[j] = yrow[F.lane + 64 * j]; s += (v[j][0] + v[j][1]) + (v[j][2] + v[j][3]); }
        const float mean = wave_sum(s) * (1.f / DM); float s2 = 0.f;
#pragma unroll
        for (int j = 0; j < 4; ++j) { v[j] = v[j] - mean; s2 += (v[j][0] * v[j][0] + v[j][1] * v[j][1]) + (v[j][2] * v[j][2] + v[j][3] * v[j][3]); }
        const float rstd = 1.f / sqrtf(wave_sum(s2) * (1.f / DM) + LN_EPS);
#pragma unroll
        for (int j = 0; j < 4; ++j) yrow[F.lane + 64 * j] = v[j] * rstd * gv[j] + bv[j];
    }
}
constexpr float C1 = 0.125f * LOG2E;
constexpr int VST_STRIDE = 144, VST_BYTES = 32 * VST_STRIDE;
typedef short v4i16_t __attribute__((ext_vector_type(4)));
__device__ __forceinline__ s16x4 vtr(const LAS unsigned char* p) { return __builtin_bit_cast(s16x4, __builtin_amdgcn_ds_read_tr16_b64_v4i16((LAS v4i16_t*)p)); }
#define MFMA32(a, b, c) __builtin_amdgcn_mfma_f32_32x32x16_bf16((a), (b), (c), 0, 0, 0)
__device__ __forceinline__ void attn_tile_core(float& m, float& l, f32x16& o0, f32x16& o1, const bf16x8 (&qf)[4], const bf16x8 (&kf)[4], const LAS unsigned char* vst, const f32x16& bias, int lane) {
    const int hi = lane >> 5;
    f32x16 S = {0.f, 0.f, 0.f, 0.f, 0.f, 0.f, 0.f, 0.f, 0.f, 0.f, 0.f, 0.f, 0.f, 0.f, 0.f, 0.f};
#pragma unroll
    for (int s = 0; s < 4; ++s) S = MFMA32(kf[s], qf[s], S);
    float mt = -INFINITY;
#pragma unroll
    for (int r = 0; r < 16; ++r) { S[r] = S[r] * C1 + bias[r]; mt = fmaxf(mt, S[r]); }
    mt = fmaxf(mt, __shfl_xor(mt, 32));
    const float mn = fmaxf(fmaxf(m, mt), -3.0e38f);
    const float sc = fast_exp2(m - mn);
    float ps = 0.f;
#pragma unroll
    for (int r = 0; r < 16; ++r) { S[r] = fast_exp2(S[r] - mn); ps += S[r]; }
    l = l * sc + ps; m = mn;
#pragma unroll
    for (int r = 0; r < 16; ++r) { o0[r] *= sc; o1[r] *= sc; }
    const bf16x8 pf0 = pack8(S[0], S[1], S[2], S[3], S[4], S[5], S[6], S[7]), pf1 = pack8(S[8], S[9], S[10], S[11], S[12], S[13], S[14], S[15]);
    const LAS unsigned char* vb = vst + (4 * hi + ((lane >> 2) & 3)) * VST_STRIDE + (16 * ((lane >> 4) & 1) + 4 * (lane & 3)) * 2;
    asm volatile("s_waitcnt lgkmcnt(0)" ::: "memory");
    s16x4 a, b; bf16x8 vf;
    a = vtr(vb); b = vtr(vb + 8 * VST_STRIDE); vf = (bf16x8){a[0], a[1], a[2], a[3], b[0], b[1], b[2], b[3]}; o0 = MFMA32(vf, pf0, o0);
    a = vtr(vb + 64); b = vtr(vb + 8 * VST_STRIDE + 64); vf = (bf16x8){a[0], a[1], a[2], a[3], b[0], b[1], b[2], b[3]}; o1 = MFMA32(vf, pf0, o1);
    a = vtr(vb + 16 * VST_STRIDE); b = vtr(vb + 24 * VST_STRIDE); vf = (bf16x8){a[0], a[1], a[2], a[3], b[0], b[1], b[2], b[3]}; o0 = MFMA32(vf, pf1, o0);
    a = vtr(vb + 16 * VST_STRIDE + 64); b = vtr(vb + 24 * VST_STRIDE + 64); vf = (bf16x8){a[0], a[1], a[2], a[3], b[0], b[1], b[2], b[3]}; o1 = MFMA32(vf, pf1, o1);
    asm volatile("s_waitcnt lgkmcnt(0)" ::: "memory");
}
constexpr int AT_OR = 0, AT_ORS = 136, AT_ML = 512 * AT_ORS, AT_VST = AT_ML + 4096, AT_END = AT_VST + NWAVES * VST_BYTES;
__device__ __forceinline__ void attn_prompt_unit(const Frame& F, const bf16* __restrict__ PROJ, bf16* __restrict__ MIX, int b, int h, int blk) {
    const int lane = F.lane, q = lane & 31, hi = lane >> 5;
    LAS unsigned char* vst = F.lds + AT_VST + F.wave * VST_BYTES;
    const float slope2 = fast_exp2(-(float)(h + 1)) * LOG2E;
    const size_t rb = (size_t)b * SEQ;
#pragma unroll 1
    for (int br = 0; br < 3; ++br) {
        const int dil = 1 << (2 * br);
#pragma unroll 1
        for (int j2 = 0; j2 < 2; ++j2) {
            const int qt = F.wave * 2 + j2;
            int r, i0;
            if (br == 0) { r = 0; i0 = qt * 32; } else if (br == 1) { r = qt >> 2; i0 = (qt & 3) * 32; } else { r = qt; i0 = 0; }
            const int qloc = r + dil * (i0 + q);
            const bf16* qp = PROJ + (rb + blk * 512 + qloc) * NPROJ + CQ + h * HD + 8 * hi;
            bf16x8 qf[4];
#pragma unroll
            for (int s = 0; s < 4; ++s) qf[s] = *(const bf16x8*)(qp + 16 * s);
            float m, l; f32x16 o0, o1;
            LAS unsigned char* orow = F.lds + AT_OR + qloc * AT_ORS + 8 * hi;
            LAS float* ml = (LAS float*)(F.lds + AT_ML) + 2 * qloc;
            if (br == 0) { m = -INFINITY; l = 0.f;
#pragma unroll
                for (int k = 0; k < 16; ++k) { o0[k] = 0.f; o1[k] = 0.f; } }
            else { m = ml[0]; l = hi ? 0.f : ml[1];
#pragma unroll
                for (int g = 0; g < 4; ++g) { const v2u w0 = *(const LAS v2u*)(orow + 16 * g), w1 = *(const LAS v2u*)(orow + 64 + 16 * g);
                    o0[4 * g] = bflo(w0.x); o0[4 * g + 1] = bfhi(w0.x); o0[4 * g + 2] = bflo(w0.y); o0[4 * g + 3] = bfhi(w0.y);
                    o1[4 * g] = bflo(w1.x); o1[4 * g + 1] = bfhi(w1.x); o1[4 * g + 2] = bflo(w1.y); o1[4 * g + 3] = bfhi(w1.y); } }
            const int gq0 = (blk * 512) / dil + i0;
#pragma unroll 1
            for (int jt = 0; jt < 5; ++jt) {
                const int gk0 = gq0 - 128 + 32 * jt;
                if (gk0 < 0) continue;
                const bf16* kp = PROJ + (rb + r + (size_t)dil * (gk0 + q)) * NPROJ + CK + h * HD + 8 * hi;
                bf16x8 kf[4];
#pragma unroll
                for (int s = 0; s < 4; ++s) kf[s] = *(const bf16x8*)(kp + 16 * s);
                const bf16* vp = PROJ + (rb + r + (size_t)dil * (gk0 + (lane >> 1))) * NPROJ + CV + h * HD + 32 * (lane & 1);
                v4u vv[4];
#pragma unroll
                for (int s = 0; s < 4; ++s) vv[s] = *(const v4u*)(vp + 8 * s);
                LAS unsigned char* vw = vst + (lane >> 1) * VST_STRIDE + 64 * (lane & 1);
#pragma unroll
                for (int s = 0; s < 4; ++s) *(LAS v4u*)(vw + 16 * s) = vv[s];
                f32x16 bias; const float sd = slope2 * (float)dil;
#pragma unroll
                for (int rr = 0; rr < 16; ++rr) { const int kvj = crow(rr, hi); const int delta = 128 - 32 * jt + q - kvj;
                    const bool valid = (jt == 0) ? (kvj >= q) : ((jt == 4) ? (kvj <= q) : true);
                    bias[rr] = valid ? -sd * (float)delta : -INFINITY; }
                attn_tile_core(m, l, o0, o1, qf, kf, vst, bias, lane);
            }
            l += __shfl_xor(l, 32);
            if (br < 2) {
                if (hi == 0) { ml[0] = m; ml[1] = l; }
#pragma unroll
                for (int g = 0; g < 4; ++g) { v2u w0, w1; w0.x = pk2(o0[4 * g], o0[4 * g + 1]); w0.y = pk2(o0[4 * g + 2], o0[4 * g + 3]); w1.x = pk2(o1[4 * g], o1[4 * g + 1]); w1.y = pk2(o1[4 * g + 2], o1[4 * g + 3]);
                    *(LAS v2u*)(orow + 16 * g) = w0; *(LAS v2u*)(orow + 64 + 16 * g) = w1; }
            } else {
                const float inv = 1.0f / l;
                bf16* op = MIX + (rb + blk * 512 + qloc) * DM + h * HD + 4 * hi;
#pragma unroll
                for (int g = 0; g < 4; ++g) { v2u w0, w1; w0.x = pk2(o0[4 * g] * inv, o0[4 * g + 1] * inv); w0.y = pk2(o0[4 * g + 2] * inv, o0[4 * g + 3] * inv);
                    w1.x = pk2(o1[4 * g] * inv, o1[4 * g + 1] * inv); w1.y = pk2(o1[4 * g + 2] * inv, o1[4 * g + 3] * inv);
                    *(v2u*)(op + 8 * g) = w0; *(v2u*)(op + 32 + 8 * g) = w1; }
            }
        }
        __syncthreads();
    }
}
constexpr int AS_MRG = NWAVES * VST_BYTES;
__device__ __forceinline__ int as_pos(int t, int j) { return t < 24 ? 16 * (4 * t + (j >> 3)) + (j & 7) : (t < 40 ? 1536 + 32 * (t - 24) + j : WBUF + j); }
__device__ __forceinline__ void attn_sample_task(const Frame& F, const bf16* __restrict__ PROJ, const float* __restrict__ cache_k, const float* __restrict__ cache_v, bf16* __restrict__ MIX, int n, int h, int half, int pair) {
    const int lane = F.lane, q = lane & 31, hi = lane >> 5, qi = q & 7;
    LAS unsigned char* vst = F.lds + F.wave * VST_BYTES;
    const float slope2 = fast_exp2(-(float)(h + 1)) * LOG2E;
    const bf16* qp = PROJ + (size_t)(MP + n * DECT + qi) * NPROJ + CQ + h * HD + 8 * hi;
    bf16x8 qf[4];
#pragma unroll
    for (int s = 0; s < 4; ++s) qf[s] = *(const bf16x8*)(qp + 16 * s);
    float m = -INFINITY, l = 0.f; f32x16 o0, o1;
#pragma unroll
    for (int k = 0; k < 16; ++k) { o0[k] = 0.f; o1[k] = 0.f; }
    const int t0 = half ? 21 : 0, t1 = half ? 41 : 21;
#pragma unroll 1
    for (int t = t0; t < t1; ++t) {
        bf16x8 kf[4];
        LAS unsigned char* vw = vst + (lane >> 1) * VST_STRIDE + 64 * (lane & 1);
        if (t < 40) {
            const int pk = as_pos(t, q), pv = as_pos(t, lane >> 1);
            const float* kp = cache_k + (((size_t)n * WBUF + pk) * NH + h) * HD + 8 * hi;
            const float* vp = cache_v + (((size_t)n * WBUF + pv) * NH + h) * HD + 32 * (lane & 1);
            f32x4 kk[8], vv[8];
#pragma unroll
            for (int s = 0; s < 4; ++s) { kk[2 * s] = *(const f32x4*)(kp + 16 * s); kk[2 * s + 1] = *(const f32x4*)(kp + 16 * s + 4); }
#pragma unroll
            for (int s = 0; s < 8; ++s) vv[s] = *(const f32x4*)(vp + 4 * s);
#pragma unroll
            for (int s = 0; s < 4; ++s) kf[s] = cvt8(kk[2 * s], kk[2 * s + 1]);
#pragma unroll
            for (int s = 0; s < 4; ++s) *(LAS bf16x8*)(vw + 16 * s) = cvt8(vv[2 * s], vv[2 * s + 1]);
        } else {
            const bf16* kp = PROJ + (size_t)(MP + n * DECT + (q & 7)) * NPROJ + CK + h * HD + 8 * hi;
            const bf16* vp = PROJ + (size_t)(MP + n * DECT + ((lane >> 1) & 7)) * NPROJ + CV + h * HD + 32 * (lane & 1);
#pragma unroll
            for (int s = 0; s < 4; ++s) kf[s] = *(const bf16x8*)(kp + 16 * s);
#pragma unroll
            for (int s = 0; s < 4; ++s) *(LAS v4u*)(vw + 16 * s) = *(const v4u*)(vp + 8 * s);
        }
        f32x16 bias;
#pragma unroll
        for (int rr = 0; rr < 16; ++rr) { const int p = as_pos(t, crow(rr, hi)); const int d = WBUF + qi - p;
            const int mult = (d >= 0) ? ((d <= 128 ? 1 : 0) + (((d & 3) == 0 && d <= 512) ? 1 : 0) + (((d & 15) == 0 && d <= 2048) ? 1 : 0)) : 0;
            const float lm = (mult == 3) ? 1.5849625007211562f : ((mult == 2) ? 1.0f : 0.0f);
            bias[rr] = mult ? (lm - slope2 * (float)d) : -INFINITY; }
        attn_tile_core(m, l, o0, o1, qf, kf, vst, bias, lane);
    }
    l += __shfl_xor(l, 32);
    LAS float* mg = (LAS float*)(F.lds + AS_MRG) + pair * 34 * 64 + lane;
    if (half) { mg[0] = m; mg[64] = l;
#pragma unroll
        for (int k = 0; k < 16; ++k) { mg[(2 + k) * 64] = o0[k]; mg[(18 + k) * 64] = o1[k]; } }
    __syncthreads();
    if (!half) {
        const float m2 = mg[0], l2 = mg[64]; const float mn = fmaxf(fmaxf(m, m2), -3.0e38f); const float a = fast_exp2(m - mn), c = fast_exp2(m2 - mn);
        const float inv = 1.0f / (l * a + l2 * c);
#pragma unroll
        for (int k = 0; k < 16; ++k) { o0[k] = (o0[k] * a + mg[(2 + k) * 64] * c) * inv; o1[k] = (o1[k] * a + mg[(18 + k) * 64] * c) * inv; }
        if (q < 8) { bf16* op = MIX + (size_t)(MP + n * DECT + q) * DM + h * HD + 4 * hi;
#pragma unroll
            for (int g = 0; g < 4; ++g) { v2u w0, w1; w0.x = pk2(o0[4 * g], o0[4 * g + 1]); w0.y = pk2(o0[4 * g + 2], o0[4 * g + 3]); w1.x = pk2(o1[4 * g], o1[4 * g + 1]); w1.y = pk2(o1[4 * g + 2], o1[4 * g + 3]);
                *(v2u*)(op + 8 * g) = w0; *(v2u*)(op + 32 + 8 * g) = w1; } }
    }
    __syncthreads();
}
constexpr int SROW = 272;
__device__ __forceinline__ float softplusf_(float x) { return x > 20.f ? x : log1pf(__expf(x)); }
__device__ __forceinline__ void ssd_dt_scan(const Frame& F, CArgs A, const float* __restrict__ DT, int row0, int g, LAS float* acs, LAS float* dtv, LAS float* atl) {
    if (F.wave < 4) {
        const int hh = F.wave, h = 4 * g + hh, lane = F.lane;
        const float dtb = A->in[I_DTB][h], a = -__expf(A->in[I_ALOG][h]);
        const float d0 = softplusf_(DT[(size_t)(row0 + lane) * 8 + h] + dtb), d1 = softplusf_(DT[(size_t)(row0 + 64 + lane) * 8 + h] + dtb);
        float c0 = d0 * a, c1 = d1 * a;
#pragma unroll
        for (int o = 1; o < 64; o <<= 1) { const float t0 = __shfl_up(c0, o), t1 = __shfl_up(c1, o); if (lane >= o) { c0 += t0; c1 += t1; } }
        c1 += __shfl(c0, 63);
        acs[hh * 128 + lane] = c0; acs[hh * 128 + 64 + lane] = c1; dtv[hh * 128 + lane] = d0; dtv[hh * 128 + 64 + lane] = d1;
        if (lane == 63) atl[hh] = c1;
    }
}
struct Conv8 { f32x4 w[4][2]; f32x4 b[2]; };
__device__ __forceinline__ void conv8_load(Conv8& c, const float* __restrict__ cw, const float* __restrict__ cb, int cidx) {
#pragma unroll
    for (int w = 0; w < 4; ++w) { c.w[w][0] = *(const f32x4*)(cw + w * CONVD + cidx); c.w[w][1] = *(const f32x4*)(cw + w * CONVD + cidx + 4); }
    c.b[0] = *(const f32x4*)(cb + cidx); c.b[1] = *(const f32x4*)(cb + cidx + 4);
}
struct Row8 { f32x4 a, b; };
__device__ __forceinline__ Row8 row8_from(const v4u r) { Row8 o; o.a = (f32x4){bflo(r.x), bfhi(r.x), bflo(r.y), bfhi(r.y)}; o.b = (f32x4){bflo(r.z), bfhi(r.z), bflo(r.w), bfhi(r.w)}; return o; }
__device__ __forceinline__ Row8 conv8_silu(const Conv8& c, const Row8& x3, const Row8& x2, const Row8& x1, const Row8& x0) {
    Row8 o; o.a = c.b[0] + c.w[0][0] * x3.a + c.w[1][0] * x2.a + c.w[2][0] * x1.a + c.w[3][0] * x0.a; o.b = c.b[1] + c.w[0][1] * x3.b + c.w[1][1] * x2.b + c.w[2][1] * x1.b + c.w[3][1] * x0.b;
#pragma unroll
    for (int k = 0; k < 4; ++k) { o.a[k] = siluf_(o.a[k]); o.b[k] = siluf_(o.b[k]); }
    return o;
}
constexpr int SS_XT = 0, SS_B = 256 * SROW, SS_C = SS_B + 128 * SROW, SS_ACS = SS_C + 128 * SROW, SS_DTV = SS_ACS + 2048, SS_ATL = SS_DTV + 2048, SS_SS = SS_ATL + 128, SS_END = SS_SS + 2048;
static_assert(SS_END <= RING_BYTES, "SSD LDS map");
__device__ __forceinline__ void ssd_states_unit(const Frame& F, CArgs A, int b, int c, int g) {
    unsigned char* ws = A->ws; const bf16* __restrict__ PROJ = (const bf16*)(ws + WS_PROJ); const float* DT = (const float*)(ws + WS_DT);
    float* STLOC = (float*)(ws + WS_STLOC); float* ATOT = (float*)(ws + WS_ATOT);
    const int row0 = b * SEQ + c * 128, lane = F.lane, hi = lane >> 5;
    LAS float* acs = (LAS float*)(F.lds + SS_ACS); LAS float* dtv = (LAS float*)(F.lds + SS_DTV); LAS float* atl = (LAS float*)(F.lds + SS_ATL);
    ssd_dt_scan(F, A, DT, row0, g, acs, dtv, atl);
    __syncthreads();
    if (F.tid < 384) {
        const int cg = F.tid % 48, lseg = F.tid / 48; const bool isx = cg < 32; const int hh = cg >> 3;
        const int cidx = isx ? g * 256 + cg * 8 : 512 + g * 128 + (cg - 32) * 8;
        Conv8 cv; conv8_load(cv, A->in[I_CONVW], A->in[I_CONVB], cidx);
        const int l0 = 16 * lseg; const bf16* src = PROJ + (size_t)row0 * NPROJ + CXB + cidx;
        const Row8 zero = {(f32x4){0.f, 0.f, 0.f, 0.f}, (f32x4){0.f, 0.f, 0.f, 0.f}};
        Row8 x3 = (c * 128 + l0 - 3 >= 0) ? row8_from(*(const v4u*)(src + (ptrdiff_t)(l0 - 3) * NPROJ)) : zero;
        Row8 x2 = (c * 128 + l0 - 2 >= 0) ? row8_from(*(const v4u*)(src + (ptrdiff_t)(l0 - 2) * NPROJ)) : zero;
        Row8 x1 = (c * 128 + l0 - 1 >= 0) ? row8_from(*(const v4u*)(src + (ptrdiff_t)(l0 - 1) * NPROJ)) : zero;
        LAS unsigned char* dst = F.lds + (isx ? SS_XT + (cg * 8) * SROW : SS_B + ((cg - 32) * 8) * SROW);
        const float at = isx ? atl[hh] : 0.f;
#pragma unroll 4
        for (int li = 0; li < 16; ++li) { const int l = l0 + li;
            const Row8 x0 = row8_from(*(const v4u*)(src + (size_t)l * NPROJ));
            Row8 s = conv8_silu(cv, x3, x2, x1, x0);
            if (isx) { const float f = dtv[hh * 128 + l] * __expf(at - acs[hh * 128 + l]); s.a = s.a * f; s.b = s.b * f; }
#pragma unroll
            for (int k = 0; k < 4; ++k) { *(LAS unsigned short*)(dst + k * SROW + 2 * l) = (unsigned short)f2bf(s.a[k]); *(LAS unsigned short*)(dst + (4 + k) * SROW + 2 * l) = (unsigned short)f2bf(s.b[k]); }
            x3 = x2; x2 = x1; x1 = x0; }
    }
    __syncthreads();
    {
        const int hh = F.wave >> 1, ph = F.wave & 1, h = 4 * g + hh;
        f32x16 acc[4];
#pragma unroll
        for (int nt = 0; nt < 4; ++nt)
#pragma unroll
            for (int k = 0; k < 16; ++k) acc[nt][k] = 0.f;
        const LAS unsigned char* ar = F.lds + SS_XT + (hh * 64 + 32 * ph + (lane & 31)) * SROW + 16 * hi;
        const LAS unsigned char* brw = F.lds + SS_B + (lane & 31) * SROW + 16 * hi;
#pragma unroll
        for (int ks = 0; ks < 8; ++ks) { const bf16x8 af = *(const LAS bf16x8*)(ar + 32 * ks);
#pragma unroll
            for (int nt = 0; nt < 4; ++nt) { const bf16x8 bf = *(const LAS bf16x8*)(brw + nt * 32 * SROW + 32 * ks); acc[nt] = MFMA32(af, bf, acc[nt]); } }
        float* o = STLOC + ((size_t)((b * 16 + c) * NH + h) * HD + 32 * ph) * DST + (lane & 31);
#pragma unroll
        for (int nt = 0; nt < 4; ++nt)
#pragma unroll
            for (int k = 0; k < 16; ++k) o[(size_t)crow(k, hi) * DST + 32 * nt] = acc[nt][k];
        if (lane == 0 && ph == 0) ATOT[(b * 16 + c) * NH + h] = atl[hh];
    }
    __syncthreads();
}
__device__ __forceinline__ void ssd_scan_unit(const Frame& F, CArgs A, int unit) {
    const int bh = unit >> 2, pq = unit & 3, b = bh >> 3, h = bh & 7;
    float* STLOC = (float*)(A->ws + WS_STLOC); const float* ATOT = (const float*)(A->ws + WS_ATOT);
    const int p = 16 * pq + (F.tid >> 5), n4 = (F.tid & 31) * 4;
    f32x4 s = {0.f, 0.f, 0.f, 0.f};
#pragma unroll 4
    for (int c = 0; c < 16; ++c) { f32x4* slot = (f32x4*)(STLOC + ((size_t)((b * 16 + c) * NH + h) * HD + p) * DST + n4);
        const f32x4 loc = *slot; *slot = s; s = s * __expf(ATOT[(b * 16 + c) * NH + h]) + loc; }
    *(f32x4*)(A->out + O_SP + ((size_t)(b * NH + h) * HD + p) * DST + n4) = s;
}
__device__ __forceinline__ void ssd_out_unit(const Frame& F, CArgs A, int b, int c, int g) {
    unsigned char* ws = A->ws; const bf16* __restrict__ PROJ = (const bf16*)(ws + WS_PROJ); const float* DT = (const float*)(ws + WS_DT);
    const float* STLOC = (const float*)(ws + WS_STLOC); bf16* MIX = (bf16*)(ws + WS_MIX);
    const int row0 = b * SEQ + c * 128, lane = F.lane, hi = lane >> 5;
    LAS float* acs = (LAS float*)(F.lds + SS_ACS); LAS float* dtv = (LAS float*)(F.lds + SS_DTV); LAS float* atl = (LAS float*)(F.lds + SS_ATL); LAS float* ssq = (LAS float*)(F.lds + SS_SS);
    ssd_dt_scan(F, A, DT, row0, g, acs, dtv, atl);
    {
        const int cg = F.tid & 63, lseg = F.tid >> 6; const int kind = cg < 32 ? 0 : (cg < 48 ? 1 : 2);
        const int cidx = kind == 0 ? g * 256 + cg * 8 : (kind == 1 ? 512 + g * 128 + (cg - 32) * 8 : 768 + g * 128 + (cg - 48) * 8);
        Conv8 cv; conv8_load(cv, A->in[I_CONVW], A->in[I_CONVB], cidx);
        const int l0 = 16 * lseg; const bf16* src = PROJ + (size_t)row0 * NPROJ + CXB + cidx;
        const Row8 zero = {(f32x4){0.f, 0.f, 0.f, 0.f}, (f32x4){0.f, 0.f, 0.f, 0.f}};
        Row8 x3 = (c * 128 + l0 - 3 >= 0) ? row8_from(*(const v4u*)(src + (ptrdiff_t)(l0 - 3) * NPROJ)) : zero;
        Row8 x2 = (c * 128 + l0 - 2 >= 0) ? row8_from(*(const v4u*)(src + (ptrdiff_t)(l0 - 2) * NPROJ)) : zero;
        Row8 x1 = (c * 128 + l0 - 1 >= 0) ? row8_from(*(const v4u*)(src + (ptrdiff_t)(l0 - 1) * NPROJ)) : zero;
        LAS unsigned char* dstx = F.lds + SS_XT + (cg * 8) * SROW;
        LAS unsigned char* dstn = F.lds + (kind == 1 ? SS_B + (cg - 32) * 16 : SS_C + (cg - 48) * 16);
#pragma unroll 4
        for (int li = 0; li < 16; ++li) { const int l = l0 + li;
            const Row8 x0 = row8_from(*(const v4u*)(src + (size_t)l * NPROJ));
            const Row8 s = conv8_silu(cv, x3, x2, x1, x0);
            if (kind == 0) {
#pragma unroll
                for (int k = 0; k < 4; ++k) { *(LAS unsigned short*)(dstx + k * SROW + 2 * l) = (unsigned short)f2bf(s.a[k]); *(LAS unsigned short*)(dstx + (4 + k) * SROW + 2 * l) = (unsigned short)f2bf(s.b[k]); }
            } else *(LAS bf16x8*)(dstn + l * SROW) = cvt8(s.a, s.b);
            x3 = x2; x2 = x1; x1 = x0; }
    }
    __syncthreads();
    const int hh = F.wave >> 1, lh = F.wave & 1, h = 4 * g + hh;
    f32x16 acc[2][2];
#pragma unroll
    for (int i = 0; i < 2; ++i)
#pragma unroll
        for (int j = 0; j < 2; ++j)
#pragma unroll
            for (int k = 0; k < 16; ++k) acc[i][j][k] = 0.f;
    const LAS unsigned char* cn = F.lds + SS_C + (lane & 31) * SROW + 16 * hi;
    const LAS unsigned char* bn = F.lds + SS_B + (lane & 31) * SROW + 16 * hi;
    {
        const float* sp = STLOC + ((size_t)((b * 16 + c) * NH + h) * HD + (lane & 31)) * DST + 8 * hi;
#pragma unroll 2
        for (int ks = 0; ks < 8; ++ks) {
            const bf16x8 cf0 = *(const LAS bf16x8*)(cn + (64 * lh) * SROW + 32 * ks), cf1 = *(const LAS bf16x8*)(cn + (64 * lh + 32) * SROW + 32 * ks);
#pragma unroll
            for (int pt = 0; pt < 2; ++pt) { const float* s_ = sp + (size_t)(32 * pt) * DST + 16 * ks; const bf16x8 af = cvt8(*(const f32x4*)s_, *(const f32x4*)(s_ + 4));
                acc[0][pt] = MFMA32(af, cf0, acc[0][pt]); acc[1][pt] = MFMA32(af, cf1, acc[1][pt]); } }
#pragma unroll
        for (int lt2 = 0; lt2 < 2; ++lt2) { const float e = __expf(acs[hh * 128 + 64 * lh + 32 * lt2 + (lane & 31)]);
#pragma unroll
            for (int pt = 0; pt < 2; ++pt)
#pragma unroll
                for (int k = 0; k < 16; ++k) acc[lt2][pt][k] *= e; }
    }
    const float dsk = A->in[I_DSKIP][h];
#pragma unroll
    for (int lt2 = 0; lt2 < 2; ++lt2) {
        const int lt = 2 * lh + lt2, lcol = 32 * lt + (lane & 31); const float acs_l = acs[hh * 128 + lcol];
#pragma unroll 1
        for (int st = 0; st <= lt; ++st) {
            f32x16 X;
#pragma unroll
            for (int k = 0; k < 16; ++k) X[k] = 0.f;
#pragma unroll
            for (int ks = 0; ks < 8; ++ks) { const bf16x8 bnf = *(const LAS bf16x8*)(bn + (32 * st) * SROW + 32 * ks), cnf = *(const LAS bf16x8*)(cn + (32 * lt) * SROW + 32 * ks); X = MFMA32(bnf, cnf, X); }
#pragma unroll
            for (int k = 0; k < 16; ++k) { const int s = 32 * st + crow(k, hi); const float as = acs[hh * 128 + s], dts = dtv[hh * 128 + s];
                X[k] = (s <= lcol) ? X[k] * __expf(fminf(acs_l - as, 0.f)) * dts : 0.f; }
            const bf16x8 pf0 = pack8(X[0], X[1], X[2], X[3], X[4], X[5], X[6], X[7]), pf1 = pack8(X[8], X[9], X[10], X[11], X[12], X[13], X[14], X[15]);
#pragma unroll
            for (int pt = 0; pt < 2; ++pt) { const LAS unsigned char* xr = F.lds + SS_XT + (hh * 64 + 32 * pt + (lane & 31)) * SROW + 64 * st + 8 * hi;
                v2u a0 = *(const LAS v2u*)(xr), a1 = *(const LAS v2u*)(xr + 16), b0 = *(const LAS v2u*)(xr + 32), b1 = *(const LAS v2u*)(xr + 48);
                const bf16x8 xf0 = __builtin_bit_cast(bf16x8, (v4u){a0.x, a0.y, a1.x, a1.y}), xf1 = __builtin_bit_cast(bf16x8, (v4u){b0.x, b0.y, b1.x, b1.y});
                acc[lt2][pt] = MFMA32(xf0, pf0, acc[lt2][pt]); acc[lt2][pt] = MFMA32(xf1, pf1, acc[lt2][pt]); }
        }
        float ss = 0.f;
#pragma unroll
        for (int pt = 0; pt < 2; ++pt)
#pragma unroll
            for (int rg = 0; rg < 4; ++rg) { const v2u zw = *(const v2u*)(PROJ + (size_t)(row0 + lcol) * NPROJ + CZ + h * HD + 32 * pt + 8 * rg + 4 * hi);
                const float z[4] = {bflo(zw.x), bfhi(zw.x), bflo(zw.y), bfhi(zw.y)};
#pragma unroll
                for (int e = 0; e < 4; ++e) { const int k = 4 * rg + e; const float xv = bf2f(*(const LAS unsigned short*)(F.lds + SS_XT + (hh * 64 + 32 * pt + crow(k, hi)) * SROW + 2 * lcol));
                    const float y = (acc[lt2][pt][k] + dsk * xv) * siluf_(z[e]); acc[lt2][pt][k] = y; ss += y * y; } }
        ss += __shfl_xor(ss, 32);
        if (hi == 0) ssq[hh * 128 + lcol] = ss;
    }
    __syncthreads();
#pragma unroll
    for (int lt2 = 0; lt2 < 2; ++lt2) {
        const int lcol = 32 * (2 * lh + lt2) + (lane & 31);
        const float tot = (ssq[lcol] + ssq[128 + lcol]) + (ssq[256 + lcol] + ssq[384 + lcol]); const float rstd = 1.0f / sqrtf(tot * (1.0f / 256.0f) + LN_EPS);
#pragma unroll
        for (int pt = 0; pt < 2; ++pt)
#pragma unroll
            for (int rg = 0; rg < 4; ++rg) { const int ch = h * HD + 32 * pt + 8 * rg + 4 * hi; const f32x4 nw = *(const f32x4*)(A->in[I_NORMW] + ch);
                v2u w; w.x = pk2(acc[lt2][pt][4 * rg] * rstd * nw[0], acc[lt2][pt][4 * rg + 1] * rstd * nw[1]); w.y = pk2(acc[lt2][pt][4 * rg + 2] * rstd * nw[2], acc[lt2][pt][4 * rg + 3] * rstd * nw[3]);
                *(v2u*)(MIX + (size_t)(row0 + lcol) * DM + 512 + ch) = w; }
    }
    __syncthreads();
}
constexpr int SP_XS = 0, SP_BS = 8192, SP_CS = 12288, SP_DTS = 16384, SP_ACS = 16512, SP_CB = 16640, SP_YOFF = 16896, SP_YV = 25088, SP_END = 33280;
__device__ __forceinline__ void ssd_sample_unit(const Frame& F, CArgs A, int n, int g) {
    unsigned char* ws = A->ws; const bf16* __restrict__ PROJ = (const bf16*)(ws + WS_PROJ); const float* DT = (const float*)(ws + WS_DT); bf16* MIX = (bf16*)(ws + WS_MIX);
    LAS float* XS = (LAS float*)(F.lds + SP_XS); LAS float* BS = (LAS float*)(F.lds + SP_BS); LAS float* CS_ = (LAS float*)(F.lds + SP_CS); LAS float* DTS = (LAS float*)(F.lds + SP_DTS);
    LAS float* ACS = (LAS float*)(F.lds + SP_ACS); LAS float* CB = (LAS float*)(F.lds + SP_CB); LAS float* YOFF = (LAS float*)(F.lds + SP_YOFF); LAS float* YV = (LAS float*)(F.lds + SP_YV);
    const int tid = F.tid, lane = F.lane; const int rowb = MP + n * DECT;
    {
        const int kind = tid < 256 ? 0 : (tid < 384 ? 1 : 2);
        const int cidx = kind == 0 ? g * 256 + tid : (kind == 1 ? 512 + g * 128 + (tid - 256) : 768 + g * 128 + (tid - 384));
        const float* cw = A->in[I_CONVW]; const float w0 = cw[cidx], w1 = cw[CONVD + cidx], w2 = cw[2 * CONVD + cidx], w3 = cw[3 * CONVD + cidx], cb = A->in[I_CONVB][cidx];
        const float* sc = A->in[I_SCONV] + (size_t)n * 3 * CONVD + cidx;
        float x3 = sc[0], x2 = sc[CONVD], x1 = sc[2 * CONVD];
        LAS float* dst = kind == 0 ? XS + tid : (kind == 1 ? BS + (tid - 256) : CS_ + (tid - 384)); const int dstride = kind == 0 ? 256 : 128;
#pragma unroll
        for (int l = 0; l < DECT; ++l) { const float x0 = bf2f(PROJ[(size_t)(rowb + l) * NPROJ + CXB + cidx]);
            dst[l * dstride] = siluf_(cb + w0 * x3 + w1 * x2 + w2 * x1 + w3 * x0);
            if (l >= DECT - 3) A->out[O_CS + ((size_t)n * 3 + (l - (DECT - 3))) * CONVD + cidx] = x0;
            x3 = x2; x2 = x1; x1 = x0; }
        if (tid < 4) { const int h = 4 * g + tid; const float dtb = A->in[I_DTB][h], a = -__expf(A->in[I_ALOG][h]); float cum = 0.f;
#pragma unroll
            for (int l = 0; l < DECT; ++l) { const float d = softplusf_(DT[(size_t)(rowb + l) * 8 + h] + dtb); cum += d * a; DTS[tid * 8 + l] = d; ACS[tid * 8 + l] = cum; } }
    }
    __syncthreads();
    if (F.wave == 0) {
        const int l = lane >> 3, s = lane & 7; float d = 0.f;
#pragma unroll 8
        for (int k = 0; k < DST; ++k) d += CS_[l * 128 + k] * BS[s * 128 + k];
        CB[lane] = d;
    }
    {
        const int hh = F.wave >> 1, ph = F.wave & 1, h = 4 * g + hh, n4 = (lane & 31) * 4, pr = 32 * ph + (lane >> 5);
        const float* h0 = A->in[I_SSSM] + ((size_t)(n * NH + h) * HD + pr) * DST + n4;
        f32x4 H[16], S[16];
#pragma unroll
        for (int k = 0; k < 16; ++k) { H[k] = *(const f32x4*)(h0 + (size_t)(2 * k) * DST); S[k] = (f32x4){0.f, 0.f, 0.f, 0.f}; }
        const float aT = ACS[hh * 8 + 7];
#pragma unroll 1
        for (int l = 0; l < DECT; ++l) {
            const f32x4 c4 = *(const LAS f32x4*)(CS_ + l * 128 + n4), b4 = *(const LAS f32x4*)(BS + l * 128 + n4);
            const float al = ACS[hh * 8 + l], el = __expf(al), f = __expf(aT - al) * DTS[hh * 8 + l];
#pragma unroll
            for (int k = 0; k < 16; ++k) { float d = (c4[0] * H[k][0] + c4[1] * H[k][1]) + (c4[2] * H[k][2] + c4[3] * H[k][3]);
                d += __shfl_xor(d, 1); d += __shfl_xor(d, 2); d += __shfl_xor(d, 4); d += __shfl_xor(d, 8); d += __shfl_xor(d, 16);
                const int p = pr + 2 * k;
                if ((lane & 31) == 0) YOFF[l * 256 + hh * 64 + p] = d * el;
                const float xf = XS[l * 256 + hh * 64 + p] * f; S[k] = S[k] + b4 * xf; }
        }
        const float eT = __expf(aT);
        float* so = A->out + O_SS + ((size_t)(n * NH + h) * HD + pr) * DST + n4;
#pragma unroll
        for (int k = 0; k < 16; ++k) *(f32x4*)(so + (size_t)(2 * k) * DST) = H[k] * eT + S[k];
    }
    __syncthreads();
#pragma unroll
    for (int e = 0; e < 4; ++e) { const int idx = tid + 512 * e, l = idx >> 8, ch = idx & 255, hh = ch >> 6, h = 4 * g + hh;
        float y = YOFF[idx] + A->in[I_DSKIP][h] * XS[idx]; const float al = ACS[hh * 8 + l];
        for (int s = 0; s <= l; ++s) y += CB[l * 8 + s] * __expf(al - ACS[hh * 8 + s]) * DTS[hh * 8 + s] * XS[s * 256 + ch];
        const float z = bf2f(PROJ[(size_t)(rowb + l) * NPROJ + CZ + g * 256 + ch]);
        YV[idx] = y * siluf_(z); }
    __syncthreads();
    {
        const int l = F.wave; const f32x4 v = *(const LAS f32x4*)(YV + l * 256 + 4 * lane);
        const float ss = wave_sum((v[0] * v[0] + v[1] * v[1]) + (v[2] * v[2] + v[3] * v[3])); const float rstd = 1.0f / sqrtf(ss * (1.0f / 256.0f) + LN_EPS);
        const f32x4 nw = *(const f32x4*)(A->in[I_NORMW] + g * 256 + 4 * lane);
        v2u w; w.x = pk2(v[0] * rstd * nw[0], v[1] * rstd * nw[1]); w.y = pk2(v[2] * rstd * nw[2], v[3] * rstd * nw[3]);
        *(v2u*)(MIX + (size_t)(rowb + l) * DM + 512 + g * 256 + 4 * lane) = w;
    }
    __syncthreads();
}
constexpr int NPH = 10;
#ifndef MK_ONE_LAUNCH
#define MK_ONE_LAUNCH 1
#endif
__global__ void __launch_bounds__(NWAVES * 64, 2) fwd_kernel(Args args_by_value) {
    extern __shared__ __attribute__((aligned(16))) unsigned char lds[];
    (void)args_by_value;
    const CArgs KA = (CArgs)__builtin_amdgcn_kernarg_segment_ptr();
#define ARGS_NOW(nm) CArgs nm = KA; asm volatile("" : "+s"(nm))
    Frame F;
    F.lds = (LAS unsigned char*)lds;
    F.MISC = (volatile LAS unsigned*)(F.lds + MISC_OFF);
    F.tid = threadIdx.x; F.lane = F.tid & 63; F.wave = __builtin_amdgcn_readfirstlane(F.tid >> 6);
    F.G = gridDim.x; { const int bx = blockIdx.x; F.vcu = (F.G % 8 == 0) ? (bx % 8) * (F.G / 8) + bx / 8 : bx; }
    F.ctl = (gu32*)(KA->ws + WS_CTL);
    for (int u = F.tid; u < (LDS_BYTES - LDSCTL_OFF) / 4; u += NWAVES * 64) ((LAS unsigned*)(F.lds + LDSCTL_OFF))[u] = 0u;
    __syncthreads();
    const int lo = KA->ph_lo, hi = KA->ph_hi;
    XcdBarrier bar; bar.bar = (unsigned*)(F.ctl + CW_BAR); bar.x = 0; bar.st = nullptr;
    if (hi - lo > 1) bar = xcd_barrier_post((unsigned*)(F.ctl + CW_BAR), F.MISC + 8);
#ifndef PH_MASK
#define PH_MASK 0xfff
#endif
#define IN(k) (((PH_MASK >> (k)) & 1) && lo <= (k) && (k) < hi)
#define SEAM(k) do { if (IN(k) && IN((k) + 1)) xcd_barrier(bar); } while (0)

    if (IN(0)) { ARGS_NOW(A); p0_prologue(F, A); SEAM(0); }
    if (IN(1)) {
        ARGS_NOW(A); unsigned char* ws = A->ws;
        pg8::Gemm g{(const bf16*)(ws + WS_H0), (const bf16*)(ws + WS_WIN), M, NPROJ, DM}; pg8::StaticOrder S; S.init(M, NPROJ, F.G, (int)blockIdx.x);
        EpiProj E{(bf16*)(ws + WS_PROJ), A->out};
        pg8::gemm_phase<EpiProj, pg8::StaticOrder, true, true>(F.lds, g, S, E);
        SEAM(1);
    }
    if (IN(2)) {
        ARGS_NOW(A); unsigned char* ws = A->ws; const bf16* PROJ = (const bf16*)(ws + WS_PROJ); bf16* MIX = (bf16*)(ws + WS_MIX);
        for (int u = F.vcu; u < 256; u += F.G) attn_prompt_unit(F, PROJ, MIX, u >> 5, (u >> 2) & 7, u & 3);
        for (int u = F.vcu; u < 256; u += F.G) { const int task = 4 * u + (F.wave >> 1); attn_sample_task(F, PROJ, A->in[I_CK], A->in[I_CV], MIX, task >> 3, task & 7, F.wave & 1, F.wave >> 1); }
        for (int u = F.vcu; u < 256; u += F.G) ssd_states_unit(F, A, u >> 5, (u >> 1) & 15, u & 1);
        for (int u = F.vcu; u < 256; u += F.G) ssd_sample_unit(F, A, u >> 1, u & 1);
        float* outp = A->out;
        for (int idx = F.vcu * 512 + F.tid; idx < NBATCH * 3 * CONVD; idx += F.G * 512) { const int b = idx / (3 * CONVD), rem = idx % (3 * CONVD), j = rem / CONVD, ch = rem % CONVD;
            outp[O_CP + idx] = bf2f(PROJ[(size_t)(b * SEQ + SEQ - 3 + j) * NPROJ + CXB + ch]); }
        SEAM(2);
    }
    if (IN(3)) { ARGS_NOW(A); for (int u = F.vcu; u < 256; u += F.G) ssd_scan_unit(F, A, u); SEAM(3); }
    if (IN(4)) { ARGS_NOW(A); for (int u = F.vcu; u < 256; u += F.G) ssd_out_unit(F, A, u >> 5, (u >> 1) & 15, u & 1); SEAM(4); }
    if (IN(5)) {
        ARGS_NOW(A); unsigned char* ws = A->ws;
        pg8::Gemm g{(const bf16*)(ws + WS_MIX), (const bf16*)(ws + WS_WOUT), M, DM, DM}; pg8::StaticOrder S; S.init(M, DM, F.G, (int)blockIdx.x);
        EpiOut E{(const bf16*)(ws + WS_H0), (bf16*)(ws + WS_V1), (float*)(ws + WS_ST1)};
        pg8::gemm_phase<EpiOut, pg8::StaticOrder, true, true>(F.lds, g, S, E);
        SEAM(5);
    }
    if (IN(6)) {
        ARGS_NOW(A); unsigned char* ws = A->ws;
        pg8::Gemm g{(const bf16*)(ws + WS_V1), (const bf16*)(ws + WS_WUP), M, DFF, DM}; pg8::StaticOrder S; S.init(M, DFF, F.G, (int)blockIdx.x);
        EpiUp E{(bf16*)(ws + WS_U), (const float*)(ws + WS_ST1), (const float*)(ws + WS_CSUP), (const float*)(ws + WS_BWUP)};
        pg8::gemm_phase<EpiUp, pg8::StaticOrder, true, true>(F.lds, g, S, E);
        SEAM(6);
    }
    if (IN(7)) {
        if ((PH_MASK >> 11) & 1) { ARGS_NOW(A); unsigned char* ws = A->ws;
          pg8::Gemm g{(const bf16*)(ws + WS_U), (const bf16*)(ws + WS_WDOWN), M, DM, DFF}; pg8::StaticOrder S; S.init(M, DM, F.G, (int)blockIdx.x);
          EpiDown E{(const bf16*)(ws + WS_V1), (bf16*)(ws + WS_V2), (const float*)(ws + WS_ST1), (float*)(ws + WS_ST2), A->in[I_LN1G], A->in[I_LN1B]};
          pg8::gemm_phase<EpiDown, pg8::StaticOrder, true, true>(F.lds, g, S, E); }
        __syncthreads();
        if ((PH_MASK >> 10) & 1) { ARGS_NOW(A); unsigned char* ws = A->ws;
          int kple = DPLE; asm volatile("" : "+s"(kple));
          pg8::Gemm g{(const bf16*)(ws + WS_PE), (const bf16*)(ws + WS_WPLE), M, DM, kple}; pg8::StaticOrder S; S.init(M, DM, F.G, (int)blockIdx.x);
          EpiPle E{(bf16*)(ws + WS_PLE)};
          pg8::gemm_phase<EpiPle, pg8::StaticOrder, true, true>(F.lds, g, S, E); }
        SEAM(7);
    }
    if (IN(8)) {
        ARGS_NOW(A); unsigned char* ws = A->ws;
        pg8::Gemm g{(const bf16*)(ws + WS_V2), (const bf16*)(ws + WS_WGATE), M, DM, DM}; pg8::StaticOrder S; S.init(M, DM, F.G, (int)blockIdx.x);
        EpiGate E{(const bf16*)(ws + WS_V2), (const bf16*)(ws + WS_PLE), A->out + O_Y, (const float*)(ws + WS_ST2), (const float*)(ws + WS_CSG), (const float*)(ws + WS_BWG), A->in[I_LN2G], A->in[I_LN2B]};
        pg8::gemm_phase<EpiGate, pg8::StaticOrder, true, true>(F.lds, g, S, E);
        SEAM(8);
    }
    if (IN(9)) { ARGS_NOW(A); p9_final_ln(F, A); }
#undef IN
#undef SEAM
}

extern "C" void kernel_launch(void* const* d_in, const int* in_sizes, int n_in, void* d_out, int out_size, void* d_ws, size_t ws_size, hipStream_t stream) {
    static int grid = 0;
    if (grid == 0) {
        if (n_in != 28 || out_size != (int)O_END || ws_size < WS_END) { fprintf(stderr, "kernel_launch: unexpected problem shape (n_in %d, out %d, ws %zu); nothing launched\n", n_in, out_size, ws_size); grid = -1; return; }
        int dev = 0, cus = 0, per_cu = 0;
        if (hipGetDevice(&dev) != hipSuccess || hipDeviceGetAttribute(&cus, hipDeviceAttributeMultiprocessorCount, dev) != hipSuccess) { fprintf(stderr, "kernel_launch: device query failed\n"); grid = -1; return; }
        if (hipFuncSetAttribute((const void*)fwd_kernel, hipFuncAttributeMaxDynamicSharedMemorySize, LDS_BYTES) != hipSuccess) { fprintf(stderr, "kernel_launch: hipFuncSetAttribute failed\n"); grid = -1; return; }
        if (hipOccupancyMaxActiveBlocksPerMultiprocessor(&per_cu, (const void*)fwd_kernel, NWAVES * 64, LDS_BYTES) != hipSuccess || per_cu < 1)
            fprintf(stderr, "kernel_launch: note: occupancy query reports %d workgroups per CU\n", per_cu);
        (void)hipGetLastError();
        grid = cus;
    }
    if (grid < 0) return;
    if (hipMemsetAsync((char*)d_ws + WS_CTL, 0, CTL_ZERO_BYTES, stream) != hipSuccess) { fprintf(stderr, "kernel_launch: memset failed\n"); return; }
    Args a{};
    for (int i = 0; i < 28; ++i) a.in[i] = (const float*)d_in[i];
    a.out = (float*)d_out; a.ws = (unsigned char*)d_ws;
#if MK_ONE_LAUNCH
    a.ph_lo = 0; a.ph_hi = NPH;
    hipLaunchKernelGGL(fwd_kernel, dim3(grid), dim3(NWAVES * 64), LDS_BYTES, stream, a);
#else
    for (int p = 0; p < NPH; ++p) { a.ph_lo = p; a.ph_hi = p + 1; hipLaunchKernelGGL(fwd_kernel, dim3(grid), dim3(NWAVES * 64), LDS_BYTES, stream, a); }
#endif
    const hipError_t le = hipPeekAtLastError();
    if (le != hipSuccess) fprintf(stderr, "kernel_launch: launch failed: %s\n", hipGetErrorName(le));
}
```

```cpp
#include <hip/hip_runtime.h>
#include <cstdio>
#include <cstdint>
namespace pg8 {
#define PG8_LAS __attribute__((address_space(3)))
typedef unsigned short bf16_t;
typedef short bf16x8 __attribute__((ext_vector_type(8)));
typedef float f32x4 __attribute__((ext_vector_type(4)));
typedef unsigned u32x4 __attribute__((ext_vector_type(4)));
constexpr int BM = 256, BK = 64, HALF = 128, HTB = HALF * BK * 2  , STAGE_BYTES = 8 * HTB, NXCD = 8, WGM = 8;

__host__ __device__ __forceinline__ int lds_byte(int r, int c) { const int st = (r >> 4) * 2 + (c >> 5), rr = r & 15, cc = c & 31, ob = rr * 64 + cc * 2; return st * 1024 + (ob ^ (((ob >> 9) & 1) << 5)); }
__host__ __device__ __forceinline__ void stage_rc(int b, int& R, int& C) { const int st = b / 1024, sb = b % 1024, swz = sb ^ (((sb >> 9) & 1) << 5); R = (st >> 1) * 16 + swz / 64; C = (st & 1) * 32 + (swz % 64) / 2; }
__host__ __device__ __forceinline__ int perm32(int rho) { const int n = rho >> 4, i = rho & 15; return 8 * (i >> 2) + 4 * n + (i & 3); }

struct Unit { int pm, pn; };
struct Gemm { const bf16_t* A; const bf16_t* Bt; int M, N, K; };

struct StaticOrder {
    int nM, nN, nwg, G, c;
    __host__ __device__ void init(int M, int N, int G_, int c_) { nM = M / BM; nN = N / BM; nwg = nM * nN; G = G_; c = c_; }
    __host__ __device__ bool next(int i, Unit& u) const {
        const long L = (long)i * G + c; if (L >= nwg) return false;
        int wgid = (int)L; { const int q = nwg / NXCD, r = nwg % NXCD, xcd = wgid % NXCD, off = wgid / NXCD; wgid = (xcd < r ? xcd * (q + 1) : r * (q + 1) + (xcd - r) * q) + off; }
        const int nig = WGM * nN, gid = wgid / nig, fm = gid * WGM, gsz = (nM - fm) < WGM ? (nM - fm) : WGM;
        u.pm = fm + ((wgid % nig) % gsz); u.pn = (wgid % nig) / gsz; return true;
    }
    __device__ __forceinline__ void a_ready(const Unit&) const {}
    __device__ __forceinline__ void done(const Unit&) const {}
};
__device__ __forceinline__ unsigned cvt_pk_bf16(float lo, float hi) { unsigned r; asm volatile("v_cvt_pk_bf16_f32 %0, %1, %2" : "=v"(r) : "v"(lo), "v"(hi)); return r; }
typedef float f32x2 __attribute__((ext_vector_type(2)));
template <class Epi, class Sched, bool ALIGN_EPI = false, bool SP2 = false>
__device__ __forceinline__ void gemm_phase(PG8_LAS unsigned char* lds, const Gemm g, const Sched& S, const Epi& E) {
    const int tid = threadIdx.x, wid = __builtin_amdgcn_readfirstlane(tid >> 6), lane = tid & 63, wr = wid >> 2, wc = wid & 3, fr = lane & 15, fq = lane >> 4;
    const int K = g.K, nt = K / BK;
    unsigned voffA[2], voffB[2];
#pragma unroll
    for (int i = 0; i < 2; ++i) { int R, C; stage_rc(tid * 16 + i * 8192, R, C); const int Rb = Epi::PERM ? ((R & ~31) + perm32(R & 31)) : R;
        voffA[i] = (unsigned)(R * K + C) * 2u; voffB[i] = (unsigned)(Rb * K + C) * 2u; }
    const size_t kstep = (size_t)(BK * 2);
    const size_t hstep = (size_t)HALF * K * 2;
    const size_t tstep = 2 * hstep;
    const unsigned ldsw = (unsigned)wid * 1024u;
    const int aoff = lds_byte(wr * 64 + fr, fq * 8), boff = lds_byte(wc * 32 + fr, fq * 8);
#define PG8_SA(b, h) (((b) * 2 + (h)) * HTB)
#define PG8_SB(b, h) ((4 + (b) * 2 + (h)) * HTB)
#define PG8_STAGE(bufoff, gbase, voff) do { _Pragma("unroll") for (int _i = 0; _i < 2; ++_i) \
        __builtin_amdgcn_global_load_lds((const unsigned*)((const char*)(gbase) + (voff)[_i]), (PG8_LAS unsigned*)(lds + (bufoff) + ldsw + _i * 8192), 16, 0, 0); } while (0)
#define PG8_LDA(dst, b, h) do { _Pragma("unroll") for (int m = 0; m < 4; ++m) _Pragma("unroll") for (int k = 0; k < 2; ++k) dst[m][k] = *(const PG8_LAS bf16x8*)(lds + PG8_SA(b, h) + aoff + m * 2048 + k * 1024); } while (0)
#define PG8_LDB(dst, b, h) do { _Pragma("unroll") for (int n = 0; n < 2; ++n) _Pragma("unroll") for (int k = 0; k < 2; ++k) dst[n][k] = *(const PG8_LAS bf16x8*)(lds + PG8_SB(b, h) + boff + n * 2048 + k * 1024); } while (0)
#define PG8_MMA(ai, bj, At, Bt) do { __builtin_amdgcn_s_setprio(1); _Pragma("unroll") for (int m = 0; m < 4; ++m) _Pragma("unroll") for (int n = 0; n < 2; ++n) _Pragma("unroll") for (int k = 0; k < 2; ++k) \
        acc[ai][bj][m][n] = __builtin_amdgcn_mfma_f32_16x16x32_bf16(Bt[n][k], At[m][k], acc[ai][bj][m][n], 0, 0, 0); __builtin_amdgcn_s_setprio(0); } while (0)
#define PG8_WAIT_V(n) asm volatile("s_waitcnt vmcnt(" #n ")" ::: "memory")
#define PG8_WAIT_L(n) asm volatile("s_waitcnt lgkmcnt(" #n ")" ::: "memory")
#define PG8_BAR __builtin_amdgcn_s_barrier()
#define PG8_SCHED __builtin_amdgcn_sched_barrier(0)
    Unit cur, nxt; int ui = 0;
    if (!S.next(0, cur)) return;
    f32x4 acc[2][2][4][2];
#pragma unroll
    for (int a = 0; a < 2; ++a)
#pragma unroll
        for (int b = 0; b < 2; ++b)
#pragma unroll
            for (int m = 0; m < 4; ++m)
#pragma unroll
                for (int n = 0; n < 2; ++n) acc[a][b][m][n] = (f32x4){0.f, 0.f, 0.f, 0.f};
    bf16x8 At[4][2], B0[2][2], B1[2][2];
    const char* cA = (const char*)g.A + (size_t)cur.pm * tstep; const char* cB = (const char*)g.Bt + (size_t)cur.pn * tstep;
    S.a_ready(cur);
    if constexpr (SP2) {
        PG8_STAGE(PG8_SB(0, 0), cB, voffB); PG8_STAGE(PG8_SB(0, 1), cB + hstep, voffB); PG8_STAGE(PG8_SA(0, 0), cA, voffA); PG8_STAGE(PG8_SA(0, 1), cA + hstep, voffA);
        if (wr == 1) PG8_BAR;
        PG8_WAIT_V(2); PG8_BAR;
        PG8_STAGE(PG8_SB(1, 0), cB + kstep, voffB); PG8_STAGE(PG8_SA(1, 0), cA + kstep, voffA); PG8_STAGE(PG8_SB(1, 1), cB + hstep + kstep, voffB);
        PG8_WAIT_V(6); PG8_BAR;
    } else {
        PG8_STAGE(PG8_SB(0, 0), cB, voffB); PG8_STAGE(PG8_SA(0, 0), cA, voffA); PG8_STAGE(PG8_SB(0, 1), cB + hstep, voffB); PG8_STAGE(PG8_SA(0, 1), cA + hstep, voffA);
        if (wr == 1) PG8_BAR;
        PG8_WAIT_V(4); PG8_BAR;
        PG8_STAGE(PG8_SB(1, 0), cB + kstep, voffB); PG8_STAGE(PG8_SA(1, 0), cA + kstep, voffA); PG8_STAGE(PG8_SB(1, 1), cB + hstep + kstep, voffB);
        PG8_WAIT_V(6); PG8_BAR;
    }
    for (;;) {
        const bool has_next = S.next(ui + 1, nxt);
        const char* nA = has_next ? (const char*)g.A + (size_t)nxt.pm * tstep : cA; const char* nB = has_next ? (const char*)g.Bt + (size_t)nxt.pn * tstep : cB;
        for (int t = 0; t < nt; t += 2) {
            const bool last = (t == nt - 2);
            const char* a1 = cA + (size_t)(t + 1) * kstep;
            const char* a2 = last ? nA : cA + (size_t)(t + 2) * kstep; const char* b2 = last ? nB : cB + (size_t)(t + 2) * kstep;
            const char* a3 = a2 + kstep; const char* b3 = b2 + kstep;
            if (last && has_next) S.a_ready(nxt);
            if constexpr (SP2) {
            PG8_LDB(B0, 0, 0); PG8_LDB(B1, 0, 1); PG8_SCHED; PG8_LDA(At, 0, 0); PG8_STAGE(PG8_SA(1, 1), a1 + hstep, voffA);
            PG8_WAIT_V(8); PG8_WAIT_L(0); PG8_BAR; PG8_MMA(0, 0, At, B0); PG8_MMA(0, 1, At, B1); PG8_BAR; PG8_SCHED;
            PG8_LDA(At, 0, 1); PG8_STAGE(PG8_SB(0, 0), b2, voffB); PG8_STAGE(PG8_SB(0, 1), b2 + hstep, voffB); PG8_STAGE(PG8_SA(0, 0), a2, voffA);
            PG8_WAIT_V(8); PG8_WAIT_L(0); PG8_BAR; PG8_MMA(1, 0, At, B0); PG8_MMA(1, 1, At, B1); PG8_BAR; PG8_SCHED;
            PG8_LDB(B0, 1, 0); PG8_LDB(B1, 1, 1); PG8_SCHED; PG8_LDA(At, 1, 0); PG8_STAGE(PG8_SA(0, 1), a2 + hstep, voffA);
            PG8_WAIT_V(8); PG8_WAIT_L(0); PG8_BAR; PG8_MMA(0, 0, At, B0); PG8_MMA(0, 1, At, B1); PG8_BAR; PG8_SCHED;
            PG8_LDA(At, 1, 1); PG8_STAGE(PG8_SB(1, 0), b3, voffB); PG8_STAGE(PG8_SB(1, 1), b3 + hstep, voffB); PG8_STAGE(PG8_SA(1, 0), a3, voffA);
            PG8_WAIT_V(8); PG8_WAIT_L(0); PG8_BAR; PG8_MMA(1, 0, At, B0); PG8_MMA(1, 1, At, B1); PG8_BAR; PG8_SCHED;
            } else {
            PG8_LDB(B0, 0, 0); PG8_SCHED; PG8_LDA(At, 0, 0); PG8_STAGE(PG8_SA(1, 1), a1 + hstep, voffA);
            PG8_WAIT_L(8); PG8_BAR; PG8_WAIT_L(0); PG8_MMA(0, 0, At, B0); PG8_BAR; PG8_SCHED;
            PG8_LDB(B1, 0, 1); PG8_STAGE(PG8_SB(0, 0), b2, voffB);
            PG8_BAR; PG8_WAIT_L(0); PG8_MMA(0, 1, At, B1); PG8_BAR;
            PG8_LDA(At, 0, 1); PG8_STAGE(PG8_SA(0, 0), a2, voffA);
            PG8_BAR; PG8_WAIT_L(0); PG8_MMA(1, 0, At, B0); PG8_BAR; PG8_SCHED;
            PG8_STAGE(PG8_SB(0, 1), b2 + hstep, voffB);
            PG8_WAIT_V(6); PG8_BAR; PG8_MMA(1, 1, At, B1); PG8_BAR;
            PG8_LDB(B0, 1, 0); PG8_SCHED; PG8_LDA(At, 1, 0); PG8_STAGE(PG8_SA(0, 1), a2 + hstep, voffA);
            PG8_WAIT_L(8); PG8_BAR; PG8_WAIT_L(0); PG8_MMA(0, 0, At, B0); PG8_BAR; PG8_SCHED;
            PG8_LDB(B1, 1, 1); PG8_STAGE(PG8_SB(1, 0), b3, voffB);
            PG8_BAR; PG8_WAIT_L(0); PG8_MMA(0, 1, At, B1); PG8_BAR;
            PG8_LDA(At, 1, 1); PG8_STAGE(PG8_SA(1, 0), a3, voffA);
            PG8_BAR; PG8_WAIT_L(0); PG8_MMA(1, 0, At, B0); PG8_BAR; PG8_SCHED;
            PG8_STAGE(PG8_SB(1, 1), b3 + hstep, voffB);
            PG8_WAIT_V(6); PG8_BAR; PG8_MMA(1, 1, At, B1); PG8_BAR;
            }
        }
        if constexpr (ALIGN_EPI) { if (wr == 0) PG8_BAR; }
        if constexpr (!Epi::AFTER_DRAIN) { E(acc, cur, wr, wc, fr, fq); S.done(cur); }
        if (!has_next) break;
#pragma unroll
        for (int a = 0; a < 2; ++a)
#pragma unroll
            for (int b = 0; b < 2; ++b)
#pragma unroll
                for (int m = 0; m < 4; ++m)
#pragma unroll
                    for (int n = 0; n < 2; ++n) acc[a][b][m][n] = (f32x4){0.f, 0.f, 0.f, 0.f};
        cur = nxt; cA = nA; cB = nB; ++ui;
        if constexpr (ALIGN_EPI) { if (wr == 1) PG8_BAR; }
    }
    PG8_WAIT_V(0);
    if constexpr (!ALIGN_EPI) { if (wr == 0) PG8_BAR; }
    PG8_BAR;
    if constexpr (Epi::AFTER_DRAIN) { E.fused(acc, cur, wr, wc, fr, fq, lds, wid, lane); S.done(cur); }
#undef PG8_SA
#undef PG8_SB
#undef PG8_STAGE
#undef PG8_LDA
#undef PG8_LDB
#undef PG8_MMA
#undef PG8_WAIT_V
#undef PG8_WAIT_L
#undef PG8_BAR
#undef PG8_SCHED
}
}
constexpr int DM = 1024, NBATCH = 8, SEQ = 2048, MP = NBATCH * SEQ, DECB = 128, DECT = 8, MS = DECB * DECT, M = MP + MS;
constexpr int NPROJ = 3072, NINP = 3080, HD = 64, NH = 8, DST = 128, DFF = 4096, DPLE = 256, CONVD = 1024, WBUF = 2048;
constexpr int CQ = 0, CK = 512, CV = 1024, CZ = 1536, CXB = 2048;
constexpr float LN_EPS = 1e-5f, ALPHA = 1.189207115002721f, LOG2E = 1.4426950408889634f;
constexpr size_t O_Y = 0, O_KP = 17825792, O_VP = 26214400, O_KS = 34603008, O_VS = 35127296, O_CP = 35651584, O_CS = 35676160, O_SP = 36069376, O_SS = 36593664, O_END = 44982272;
constexpr size_t MiB = 1u << 20;
constexpr size_t WS_CTL = 0, CTL_ZERO_BYTES = 1 * MiB;
constexpr size_t WS_ST1 = 65536, WS_ST2 = 262144, WS_CSUP = 524288, WS_BWUP = 540672, WS_CSG = 557056, WS_BWG = 561152;
constexpr size_t WS_WIN = 2 * MiB, WS_WOUT = 8 * MiB, WS_WUP = 10 * MiB, WS_WDOWN = 18 * MiB, WS_WGATE = 26 * MiB, WS_WPLE = 28 * MiB;
constexpr size_t WS_DT = 29 * MiB, WS_ATOT = 30 * MiB, WS_H0 = 32 * MiB, WS_PE = 66 * MiB, WS_PROJ = 76 * MiB, WS_MIX = 178 * MiB, WS_V1 = 212 * MiB, WS_V2 = 246 * MiB;
constexpr size_t WS_PLE = 280 * MiB, WS_STLOC = 314 * MiB, WS_U = 346 * MiB, WS_END = 482 * MiB;
constexpr int CW_TMO = 0, CW_BAR = 4096;
constexpr int RING_BYTES = 151552;
constexpr int LDSCTL_OFF = RING_BYTES, MISC_OFF = LDSCTL_OFF + 320;
constexpr int LDS_BYTES = 155648;
constexpr int NWAVES = 8;

#define GAS __attribute__((address_space(1)))
#define LAS __attribute__((address_space(3)))
typedef unsigned short bf16;
typedef unsigned v4u __attribute__((ext_vector_type(4)));
typedef unsigned v2u __attribute__((ext_vector_type(2)));
typedef float f32x4 __attribute__((ext_vector_type(4)));
typedef float f32x16 __attribute__((ext_vector_type(16)));
typedef short bf16x8 __attribute__((ext_vector_type(8)));
typedef short s16x4 __attribute__((ext_vector_type(4)));
typedef GAS unsigned gu32;
#define RLX_AGENT __ATOMIC_RELAXED, __HIP_MEMORY_SCOPE_AGENT
#define LDS_WAIT() asm volatile("s_waitcnt lgkmcnt(0)" ::: "memory")
#define VM_WAIT() asm volatile("s_waitcnt vmcnt(0)" ::: "memory")
__device__ __forceinline__ unsigned f2bf(float f) { unsigned u = __builtin_bit_cast(unsigned, f); return (u + 0x7fffu + ((u >> 16) & 1u)) >> 16; }
typedef float f32x2_t __attribute__((ext_vector_type(2))); typedef __bf16 bf16x2_t __attribute__((ext_vector_type(2)));
__device__ __forceinline__ unsigned pk2(float lo, float hi) { f32x2_t v = {lo, hi}; bf16x2_t b = __builtin_convertvector(v, bf16x2_t); return __builtin_bit_cast(unsigned, b); }
__device__ __forceinline__ float bf2f(unsigned short h) { return __builtin_bit_cast(float, (unsigned)h << 16); }
__device__ __forceinline__ float bflo(unsigned w) { return __builtin_bit_cast(float, w << 16); }
__device__ __forceinline__ float bfhi(unsigned w) { return __builtin_bit_cast(float, w & 0xffff0000u); }
__device__ __forceinline__ float fast_exp2(float x) { return __builtin_amdgcn_exp2f(x); }
__device__ __forceinline__ float fast_exp(float x) { return __builtin_amdgcn_exp2f(x * LOG2E); }
__device__ __forceinline__ float sigmoidf_(float x) { return 1.0f / (1.0f + fast_exp(-x)); }
__device__ __forceinline__ float siluf_(float x) { return x * sigmoidf_(x); }
__device__ __forceinline__ int crow(int r, int hi) { return (r & 3) + 8 * (r >> 2) + 4 * hi; }
__device__ __forceinline__ float wave_sum(float v) {
#pragma unroll
    for (int o = 1; o < 64; o <<= 1) v += __shfl_xor(v, o);
    return v;
}
__device__ __forceinline__ bf16x8 pack8(float a0, float a1, float a2, float a3, float a4, float a5, float a6, float a7) {
    v4u w; w.x = pk2(a0, a1); w.y = pk2(a2, a3); w.z = pk2(a4, a5); w.w = pk2(a6, a7); return __builtin_bit_cast(bf16x8, w);
}
__device__ __forceinline__ bf16x8 cvt8(f32x4 a, f32x4 b) { return pack8(a[0], a[1], a[2], a[3], b[0], b[1], b[2], b[3]); }
#define EPI_ARGS const pg8::f32x4 (&acc)[2][2][4][2], const pg8::Unit& u, int wr, int wc, int fr, int fq
__device__ __forceinline__ v4u pack_acc8(const f32x4 a, const f32x4 b) { v4u w; w.x = pk2(a[0], a[1]); w.y = pk2(a[2], a[3]); w.z = pk2(b[0], b[1]); w.w = pk2(b[2], b[3]); return w; }
__device__ __forceinline__ void row_stats(float mu_s, float s2, float& mu, float& rs) { mu = mu_s * (1.0f / DM); const float var = s2 * (1.0f / DM) - mu * mu; rs = 1.0f / sqrtf(fmaxf(var, 0.f) + LN_EPS); }

struct EpiProj {
    static constexpr bool PERM = true, AFTER_DRAIN = false;
    bf16* P; float* out;
    __device__ __forceinline__ void operator()(EPI_ARGS) const {
        const int pn = u.pn; const bool kv = (pn >= 2 && pn < 6); const bool isv = pn >= 4; const bool prompt = u.pm < (MP / 256);
        const int col0 = pn * 256 + wc * 32 + 8 * fq; const int row0 = u.pm * 256 + wr * 64 + fr;
        float* ob = out + (prompt ? (isv ? O_VP : O_KP) : (isv ? O_VS : O_KS)); const int rsub = prompt ? 0 : MP; const int csub = isv ? CV : CK;
#pragma unroll
        for (int ai = 0; ai < 2; ++ai)
#pragma unroll
            for (int m = 0; m < 4; ++m) { const int row = row0 + ai * 128 + m * 16;
#pragma unroll
                for (int bj = 0; bj < 2; ++bj) { const int col = col0 + bj * 128;
                    *(v4u*)(P + (size_t)row * NPROJ + col) = pack_acc8(acc[ai][bj][m][0], acc[ai][bj][m][1]);
                    if (kv) { float* o = ob + (size_t)(row - rsub) * 512 + (col - csub); *(f32x4*)o = acc[ai][bj][m][0]; *(f32x4*)(o + 4) = acc[ai][bj][m][1]; } } }
    }
};
struct EpiOut {
    static constexpr bool PERM = true, AFTER_DRAIN = false;
    const bf16* H0; bf16* V1; float* ST;
    __device__ __forceinline__ void operator()(EPI_ARGS) const {
        const int col0 = u.pn * 256 + wc * 32 + 8 * fq; const int row0 = u.pm * 256 + wr * 64 + fr;
#pragma unroll
        for (int ai = 0; ai < 2; ++ai)
#pragma unroll
            for (int m = 0; m < 4; ++m) { const int row = row0 + ai * 128 + m * 16; float s = 0.f, s2 = 0.f;
#pragma unroll
                for (int bj = 0; bj < 2; ++bj) { const int col = col0 + bj * 128; const size_t off = (size_t)row * DM + col;
                    const v4u hw = *(const v4u*)(H0 + off); f32x4 a = acc[ai][bj][m][0], b = acc[ai][bj][m][1];
                    a[0] += ALPHA * bflo(hw.x); a[1] += ALPHA * bfhi(hw.x); a[2] += ALPHA * bflo(hw.y); a[3] += ALPHA * bfhi(hw.y);
                    b[0] += ALPHA * bflo(hw.z); b[1] += ALPHA * bfhi(hw.z); b[2] += ALPHA * bflo(hw.w); b[3] += ALPHA * bfhi(hw.w);
                    s += (a[0] + a[1]) + (a[2] + a[3]) + (b[0] + b[1]) + (b[2] + b[3]);
                    s2 += (a[0] * a[0] + a[1] * a[1]) + (a[2] * a[2] + a[3] * a[3]) + (b[0] * b[0] + b[1] * b[1]) + (b[2] * b[2] + b[3] * b[3]);
                    *(v4u*)(V1 + off) = pack_acc8(a, b); }
                s += __shfl_xor(s, 16); s += __shfl_xor(s, 32); s2 += __shfl_xor(s2, 16); s2 += __shfl_xor(s2, 32);
                if (fq == 0) { unsafeAtomicAdd(ST + 2 * row, s); unsafeAtomicAdd(ST + 2 * row + 1, s2); } }
    }
};
struct EpiUp {
    static constexpr bool PERM = true, AFTER_DRAIN = false;
    bf16* U; const float* ST; const float* cs; const float* bw;
    __device__ __forceinline__ void operator()(EPI_ARGS) const {
        const int col0 = u.pn * 256 + wc * 32 + 8 * fq; const int row0 = u.pm * 256 + wr * 64 + fr;
#pragma unroll
        for (int bj = 0; bj < 2; ++bj) { const int col = col0 + bj * 128;
            const f32x4 c0 = *(const f32x4*)(cs + col), c1 = *(const f32x4*)(cs + col + 4), w0 = *(const f32x4*)(bw + col), w1 = *(const f32x4*)(bw + col + 4);
#pragma unroll
            for (int ai = 0; ai < 2; ++ai)
#pragma unroll
                for (int m = 0; m < 4; ++m) { const int row = row0 + ai * 128 + m * 16; float mu, rs; row_stats(ST[2 * row], ST[2 * row + 1], mu, rs);
                    f32x4 a = (acc[ai][bj][m][0] - mu * c0) * rs + w0, b = (acc[ai][bj][m][1] - mu * c1) * rs + w1;
#pragma unroll
                    for (int k = 0; k < 4; ++k) { a[k] = fmaxf(a[k], 0.f); a[k] *= a[k]; b[k] = fmaxf(b[k], 0.f); b[k] *= b[k]; }
                    *(v4u*)(U + (size_t)row * DFF + col) = pack_acc8(a, b); } }
    }
};
struct EpiDown {
    static constexpr bool PERM = true, AFTER_DRAIN = false;
    const bf16* V1; bf16* V2; const float* ST1; float* ST2; const float* g; const float* bb;
    __device__ __forceinline__ void operator()(EPI_ARGS) const {
        const int col0 = u.pn * 256 + wc * 32 + 8 * fq; const int row0 = u.pm * 256 + wr * 64 + fr;
        float ss[2][4], ss2[2][4];
#pragma unroll
        for (int ai = 0; ai < 2; ++ai)
#pragma unroll
            for (int m = 0; m < 4; ++m) { ss[ai][m] = 0.f; ss2[ai][m] = 0.f; }
#pragma unroll
        for (int bj = 0; bj < 2; ++bj) { const int col = col0 + bj * 128;
            const f32x4 g0 = *(const f32x4*)(g + col), g1 = *(const f32x4*)(g + col + 4), b0 = *(const f32x4*)(bb + col), b1 = *(const f32x4*)(bb + col + 4);
#pragma unroll
            for (int ai = 0; ai < 2; ++ai)
#pragma unroll
                for (int m = 0; m < 4; ++m) { const int row = row0 + ai * 128 + m * 16; float mu, rs; row_stats(ST1[2 * row], ST1[2 * row + 1], mu, rs);
                    const size_t off = (size_t)row * DM + col; const v4u hw = *(const v4u*)(V1 + off);
                    f32x4 x0 = {bflo(hw.x), bfhi(hw.x), bflo(hw.y), bfhi(hw.y)}, x1 = {bflo(hw.z), bfhi(hw.z), bflo(hw.w), bfhi(hw.w)};
                    const f32x4 a = acc[ai][bj][m][0] + ALPHA * ((x0 - mu) * rs * g0 + b0), b = acc[ai][bj][m][1] + ALPHA * ((x1 - mu) * rs * g1 + b1);
                    ss[ai][m] += (a[0] + a[1]) + (a[2] + a[3]) + (b[0] + b[1]) + (b[2] + b[3]);
                    ss2[ai][m] += (a[0] * a[0] + a[1] * a[1]) + (a[2] * a[2] + a[3] * a[3]) + (b[0] * b[0] + b[1] * b[1]) + (b[2] * b[2] + b[3] * b[3]);
                    *(v4u*)(V2 + off) = pack_acc8(a, b); } }
#pragma unroll
        for (int ai = 0; ai < 2; ++ai)
#pragma unroll
            for (int m = 0; m < 4; ++m) { const int row = row0 + ai * 128 + m * 16; float s = ss[ai][m], s2 = ss2[ai][m];
                s += __shfl_xor(s, 16); s += __shfl_xor(s, 32); s2 += __shfl_xor(s2, 16); s2 += __shfl_xor(s2, 32);
                if (fq == 0) { unsafeAtomicAdd(ST2 + 2 * row, s); unsafeAtomicAdd(ST2 + 2 * row + 1, s2); } }
    }
};
struct EpiPle {
    static constexpr bool PERM = true, AFTER_DRAIN = false;
    bf16* O;
    __device__ __forceinline__ void operator()(EPI_ARGS) const {
        const int col0 = u.pn * 256 + wc * 32 + 8 * fq; const int row0 = u.pm * 256 + wr * 64 + fr;
#pragma unroll
        for (int ai = 0; ai < 2; ++ai)
#pragma unroll
            for (int m = 0; m < 4; ++m)
#pragma unroll
                for (int bj = 0; bj < 2; ++bj) *(v4u*)(O + (size_t)(row0 + ai * 128 + m * 16) * DM + col0 + bj * 128) = pack_acc8(acc[ai][bj][m][0], acc[ai][bj][m][1]);
    }
};
struct EpiGate {
    static constexpr bool PERM = true, AFTER_DRAIN = false;
    const bf16* V2; const bf16* PLE; float* Y; const float* ST2; const float* cs; const float* bw; const float* g; const float* bb;
    __device__ __forceinline__ void operator()(EPI_ARGS) const {
        const int col0 = u.pn * 256 + wc * 32 + 8 * fq; const int row0 = u.pm * 256 + wr * 64 + fr;
#pragma unroll
        for (int bj = 0; bj < 2; ++bj) { const int col = col0 + bj * 128;
            const f32x4 c0 = *(const f32x4*)(cs + col), c1 = *(const f32x4*)(cs + col + 4), w0 = *(const f32x4*)(bw + col), w1 = *(const f32x4*)(bw + col + 4);
            const f32x4 g0 = *(const f32x4*)(g + col), g1 = *(const f32x4*)(g + col + 4), b0 = *(const f32x4*)(bb + col), b1 = *(const f32x4*)(bb + col + 4);
#pragma unroll
            for (int ai = 0; ai < 2; ++ai)
#pragma unroll
                for (int m = 0; m < 4; ++m) { const int row = row0 + ai * 128 + m * 16; float mu, rs; row_stats(ST2[2 * row], ST2[2 * row + 1], mu, rs);
                    const size_t off = (size_t)row * DM + col; const v4u hw = *(const v4u*)(V2 + off), pw = *(const v4u*)(PLE + off);
                    f32x4 x0 = {bflo(hw.x), bfhi(hw.x), bflo(hw.y), bfhi(hw.y)}, x1 = {bflo(hw.z), bfhi(hw.z), bflo(hw.w), bfhi(hw.w)};
                    f32x4 p0 = {bflo(pw.x), bfhi(pw.x), bflo(pw.y), bfhi(pw.y)}, p1 = {bflo(pw.z), bfhi(pw.z), bflo(pw.w), bfhi(pw.w)};
                    f32x4 ga = (acc[ai][bj][m][0] - mu * c0) * rs + w0, gb = (acc[ai][bj][m][1] - mu * c1) * rs + w1;
#pragma unroll
                    for (int k = 0; k < 4; ++k) { ga[k] = sigmoidf_(ga[k]); gb[k] = sigmoidf_(gb[k]); }
                    const f32x4 a = ALPHA * ((x0 - mu) * rs * g0 + b0) + ga * p0, b = ALPHA * ((x1 - mu) * rs * g1 + b1) + gb * p1;
                    *(f32x4*)(Y + off) = a; *(f32x4*)(Y + off + 4) = b; } }
    }
};
#define XB_TMO      128
#define XB_XCNT(j)  (256  + 64 * (j))
#define XB_XSUB(j)  (1280 + 64 * (j))
#define XB_XGEN(j)  (2304 + 64 * (j))
#define XB_TOP      3328
#define XB_TOPGEN   3392
#define XCD_BAR_WORDS 3456
#define XB_SPIN_CAP (1u << 18)

__device__ __forceinline__ unsigned xb_ld(unsigned* p)              { return __hip_atomic_load(p, __ATOMIC_RELAXED, __HIP_MEMORY_SCOPE_AGENT); }
__device__ __forceinline__ unsigned xb_add(unsigned* p, unsigned v) { return __hip_atomic_fetch_add(p, v, __ATOMIC_RELAXED, __HIP_MEMORY_SCOPE_AGENT); }
__device__ __forceinline__ unsigned xb_xcc_id() { return (unsigned)__builtin_amdgcn_s_getreg((3 << 11) | 20) & 0xFu; }
#define XB_SPIN(cond, bar) do { unsigned _sp = 0; while (cond) { __builtin_amdgcn_s_sleep(1); \
    if ((++_sp & 255u) == 0u) { if (xb_ld(&(bar)[XB_TMO])) break; if (_sp > XB_SPIN_CAP) { atomicAdd(&(bar)[XB_TMO], 1u); break; } } } } while (0)

struct XcdBarrier {
    unsigned* bar; unsigned x;
    volatile LAS unsigned* st;
};

__device__ __forceinline__ XcdBarrier xcd_barrier_post(unsigned* bar, volatile LAS unsigned* st) {
    XcdBarrier b; b.bar = bar; b.x = xb_xcc_id(); b.st = st;
    if (threadIdx.x == 0) (void)xb_add(&bar[XB_XCNT(b.x)], 1u);
    return b;
}
__device__ __forceinline__ void xcd_barrier_complete(unsigned* bar, unsigned x, unsigned& nloc, unsigned& nx) {
    const unsigned G = gridDim.x * gridDim.y * gridDim.z;
    unsigned sum, cnt, mine, sp = 0u;
    for (;;) {
        sum = 0u; cnt = 0u; mine = 0u;
#pragma unroll
        for (unsigned j = 0; j < 16; ++j) { const unsigned c = xb_ld(&bar[XB_XCNT(j)]); sum += c; cnt += (c > 0u) ? 1u : 0u; mine = (j == x) ? c : mine; }
        if (sum == G) break;
        __builtin_amdgcn_s_sleep(1);
        if ((++sp & 255u) == 0u) { if (xb_ld(&bar[XB_TMO])) break; if (sp > XB_SPIN_CAP) { atomicAdd(&bar[XB_TMO], 1u); break; } }
    }
    nloc = mine > 0u ? mine : 1u; nx = cnt > 0u ? cnt : 1u;
}

__device__ __forceinline__ void xcd_barrier(const XcdBarrier& b) {
    asm volatile("s_waitcnt vmcnt(0)" ::: "memory");
    __syncthreads();
    if (threadIdx.x == 0) {
        unsigned* bar = b.bar;
        __builtin_amdgcn_s_waitcnt(0);
        unsigned nloc = b.st[0], nx = b.st[1];
        if (nloc == 0u) { xcd_barrier_complete(bar, b.x, nloc, nx); b.st[0] = nloc; b.st[1] = nx; }
        const unsigned old = xb_add(&bar[XB_XSUB(b.x)], 1u);
        const unsigned gen = old / nloc;
        if (old + 1u == (gen + 1u) * nloc) {
            __builtin_amdgcn_fence(__ATOMIC_RELEASE, "agent");
            asm volatile("s_waitcnt vmcnt(0)" ::: "memory");
            const unsigned og = xb_add(&bar[XB_TOP], 1u);
            const unsigned tg = og / nx;
            if (og + 1u == (tg + 1u) * nx) xb_add(&bar[XB_TOPGEN], 1u);
            else XB_SPIN(xb_ld(&bar[XB_TOPGEN]) == tg, bar);
            __builtin_amdgcn_fence(__ATOMIC_ACQUIRE, "agent");
            xb_add(&bar[XB_XGEN(b.x)], 1u);
            asm volatile("s_waitcnt vmcnt(0)" ::: "memory");
        } else {
            XB_SPIN(xb_ld(&bar[XB_XGEN(b.x)]) == gen, bar);
            __builtin_amdgcn_fence(__ATOMIC_ACQUIRE, "agent");
            asm volatile("s_waitcnt vmcnt(0)" ::: "memory");
        }
    }
    __syncthreads();
}
struct Args { const float* in[28]; float* out; unsigned char* ws; int ph_lo, ph_hi; };
typedef const __attribute__((address_space(4))) Args* CArgs;
struct Frame { LAS unsigned char* lds; volatile LAS unsigned* MISC; gu32* ctl; int tid, lane, wave, vcu, G; };
enum { I_XP = 0, I_XS, I_CK, I_CV, I_SCONV, I_SSSM, I_PP, I_PS, I_LNG, I_LNB, I_WIN, I_CONVW, I_CONVB, I_DTB, I_ALOG, I_DSKIP, I_NORMW, I_WOUT, I_LN1G, I_LN1B, I_WUP, I_WDOWN, I_LN2G, I_LN2B, I_WGATE, I_WPLE, I_LN3G, I_LN3B };

template <bool FOLD>
__device__ __forceinline__ void p0_transpose_item(const float* W, int K, int N, int ldw, bf16* WT, LAS float* scr, int item, int lane, const float* g, const float* bvec, float* cs, float* bw) {
    const int nblk = N / 32, kb = item / nblk, nb = item % nblk, k0 = 64 * kb, n0 = 32 * nb;
    float csp = 0.f, bwp = 0.f;
#pragma unroll 8
    for (int i = 0; i < 32; ++i) { const int kk = 2 * i + (lane >> 5); float w = W[(size_t)(k0 + kk) * ldw + n0 + (lane & 31)];
        if (FOLD) { const float gk = g[k0 + kk], bk = bvec[k0 + kk]; bwp += w * bk; w *= gk; csp += w; }
        scr[kk * 33 + (lane & 31)] = w; }
    if (FOLD) { csp += __shfl_xor(csp, 32); bwp += __shfl_xor(bwp, 32); if (lane < 32) { unsafeAtomicAdd(cs + n0 + lane, csp); unsafeAtomicAdd(bw + n0 + lane, bwp); } }
    LDS_WAIT(); asm volatile("" ::: "memory");
    const int c = lane & 7;
#pragma unroll
    for (int j = 0; j < 4; ++j) { const int n = (lane >> 3) + 8 * j; const LAS float* s = scr + (8 * c) * 33 + n;
        v4u o; o.x = pk2(s[0 * 33], s[1 * 33]); o.y = pk2(s[2 * 33], s[3 * 33]); o.z = pk2(s[4 * 33], s[5 * 33]); o.w = pk2(s[6 * 33], s[7 * 33]);
        *(v4u*)(WT + (size_t)(n0 + n) * K + k0 + 8 * c) = o; }
    LDS_WAIT(); asm volatile("" ::: "memory");
}
__device__ __forceinline__ void p0_prologue(const Frame& F, CArgs A) {
    unsigned char* ws = A->ws;
    LAS float* scr = (LAS float*)(F.lds + F.wave * 8448);
    const int gw = F.vcu * NWAVES + F.wave, NGW = F.G * NWAVES;
    constexpr int I_IN = (DM / 64) * (NPROJ / 32), I_O = (DM / 64) * (DM / 32), I_UP = (DM / 64) * (DFF / 32), I_DN = (DFF / 64) * (DM / 32), I_G = I_O, I_PL = (DPLE / 64) * (DM / 32);
    constexpr int NITEMS = I_IN + I_O + I_UP + I_DN + I_G + I_PL;
    for (int it = gw; it < NITEMS; it += NGW) {
        int r = it;
        if (r < I_IN) { p0_transpose_item<false>(A->in[I_WIN], DM, NPROJ, NINP, (bf16*)(ws + WS_WIN), scr, r, F.lane, nullptr, nullptr, nullptr, nullptr); continue; } r -= I_IN;
        if (r < I_O) { p0_transpose_item<false>(A->in[I_WOUT], DM, DM, DM, (bf16*)(ws + WS_WOUT), scr, r, F.lane, nullptr, nullptr, nullptr, nullptr); continue; } r -= I_O;
        if (r < I_UP) { p0_transpose_item<true>(A->in[I_WUP], DM, DFF, DFF, (bf16*)(ws + WS_WUP), scr, r, F.lane, A->in[I_LN1G], A->in[I_LN1B], (float*)(ws + WS_CSUP), (float*)(ws + WS_BWUP)); continue; } r -= I_UP;
        if (r < I_DN) { p0_transpose_item<false>(A->in[I_WDOWN], DFF, DM, DM, (bf16*)(ws + WS_WDOWN), scr, r, F.lane, nullptr, nullptr, nullptr, nullptr); continue; } r -= I_DN;
        if (r < I_G) { p0_transpose_item<true>(A->in[I_WGATE], DM, DM, DM, (bf16*)(ws + WS_WGATE), scr, r, F.lane, A->in[I_LN2G], A->in[I_LN2B], (float*)(ws + WS_CSG), (float*)(ws + WS_BWG)); continue; } r -= I_G;
        p0_transpose_item<false>(A->in[I_WPLE], DPLE, DM, DM, (bf16*)(ws + WS_WPLE), scr, r, F.lane, nullptr, nullptr, nullptr, nullptr);
    }
    LAS float* wdt = (LAS float*)(F.lds + 69632);
    for (int idx = F.tid; idx < 8192; idx += NWAVES * 64) wdt[idx] = A->in[I_WIN][(size_t)(idx >> 3) * NINP + NPROJ + (idx & 7)];
    __syncthreads();
    f32x4 gv[4], bv[4];
#pragma unroll
    for (int j = 0; j < 4; ++j) { gv[j] = ((const f32x4*)A->in[I_LNG])[F.lane + 64 * j]; bv[j] = ((const f32x4*)A->in[I_LNB])[F.lane + 64 * j]; }
    bf16* H0 = (bf16*)(ws + WS_H0); bf16* PE = (bf16*)(ws + WS_PE); float* DT = (float*)(ws + WS_DT);
    for (int m = gw; m < M; m += NGW) {
        const float* xrow = m < MP ? A->in[I_XP] + (size_t)m * DM : A->in[I_XS] + (size_t)(m - MP) * DM;
        f32x4 v[4]; float s = 0.f;
#pragma unroll
        for (int j = 0; j < 4; ++j) { v[j] = ((const f32x4*)xrow)[F.lane + 64 * j]; s += (v[j][0] + v[j][1]) + (v[j][2] + v[j][3]); }
        const float mean = wave_sum(s) * (1.f / DM); float s2 = 0.f;
#pragma unroll
        for (int j = 0; j < 4; ++j) { v[j] = v[j] - mean; s2 += (v[j][0] * v[j][0] + v[j][1] * v[j][1]) + (v[j][2] * v[j][2] + v[j][3] * v[j][3]); }
        const float rstd = 1.f / sqrtf(wave_sum(s2) * (1.f / DM) + LN_EPS);
        float d[8];
#pragma unroll
        for (int q = 0; q < 8; ++q) d[q] = 0.f;
        unsigned long long* o8 = (unsigned long long*)(H0 + (size_t)m * DM) + F.lane;
#pragma unroll
        for (int j = 0; j < 4; ++j) { v[j] = v[j] * rstd * gv[j] + bv[j];
            o8[64 * j] = (unsigned long long)pk2(v[j][0], v[j][1]) | ((unsigned long long)pk2(v[j][2], v[j][3]) << 32);
#pragma unroll
            for (int e = 0; e < 4; ++e) { const LAS float* wr_ = wdt + (4 * F.lane + 256 * j + e) * 8; const f32x4 w0 = *(const LAS f32x4*)wr_, w1 = *(const LAS f32x4*)(wr_ + 4);
                d[0] += v[j][e] * w0[0]; d[1] += v[j][e] * w0[1]; d[2] += v[j][e] * w0[2]; d[3] += v[j][e] * w0[3];
                d[4] += v[j][e] * w1[0]; d[5] += v[j][e] * w1[1]; d[6] += v[j][e] * w1[2]; d[7] += v[j][e] * w1[3]; } }
#pragma unroll
        for (int q = 0; q < 8; ++q) d[q] = wave_sum(d[q]);
        if (F.lane == 0) { *(f32x4*)(DT + (size_t)m * 8) = (f32x4){d[0], d[1], d[2], d[3]}; *(f32x4*)(DT + (size_t)m * 8 + 4) = (f32x4){d[4], d[5], d[6], d[7]}; }
        const float* prow = m < MP ? A->in[I_PP] + (size_t)m * DPLE : A->in[I_PS] + (size_t)(m - MP) * DPLE;
        const f32x4 pv = ((const f32x4*)prow)[F.lane];
        ((unsigned long long*)(PE + (size_t)m * DPLE))[F.lane] = (unsigned long long)pk2(pv[0], pv[1]) | ((unsigned long long)pk2(pv[2], pv[3]) << 32);
    }
}
__device__ __forceinline__ void p9_final_ln(const Frame& F, CArgs A) {
    const int gw = F.vcu * NWAVES + F.wave, NGW = F.G * NWAVES;
    f32x4 gv[4], bv[4];
#pragma unroll
    for (int j = 0; j < 4; ++j) { gv[j] = ((const f32x4*)A->in[I_LN3G])[F.lane + 64 * j]; bv[j] = ((const f32x4*)A->in[I_LN3B])[F.lane + 64 * j]; }
    for (int m = gw; m < M; m += NGW) {
        f32x4* yrow = (f32x4*)(A->out + O_Y + (size_t)m * DM);
        f32x4 v[4]; float s = 0.f;
#pragma unroll
        for (int j = 0; j < 4; ++j) { v[j] = yrow[F.lane + 64 * j]; s += (v[j][0] + v[j][1]) + (v[j][2] + v[j][3]); }
        const float mean = wave_sum(s) * (1.f / DM); float s2 = 0.f;
#pragma unroll
        for (int j = 0; j < 4; ++j) { v[j] = v[j] - mean; s2 += (v[j][0] * v[j][0] + v[j][1] * v[j][1]) + (v[j][2] * v[j][2] + v[j][3] * v[j][3]); }
        const float rstd = 1.f / sqrtf(wave_sum(s2) * (1.f / DM) + LN_EPS);
#pragma unroll
        for (int j = 0; j < 4; ++j) yrow[F.lane + 64 * j] = v[j] * rstd * gv[j] + bv[j];
    }
}
constexpr float C1 = 0.125f * LOG2E;
constexpr int VST_STRIDE = 144, VST_BYTES = 32 * VST_STRIDE;
typedef short v4i16_t __attribute__((ext_vector_type(4)));
__device__ __forceinline__ s16x4 vtr(const LAS unsigned char* p) { return __builtin_bit_cast(s16x4, __builtin_amdgcn_ds_read_tr16_b64_v4i16((LAS v4i16_t*)p)); }
#define MFMA32(a, b, c) __builtin_amdgcn_mfma_f32_32x32x16_bf16((a), (b), (c), 0, 0, 0)
__device__ __forceinline__ void attn_tile_core(float& m, float& l, f32x16& o0, f32x16& o1, const bf16x8 (&qf)[4], const bf16x8 (&kf)[4], const LAS unsigned char* vst, const f32x16& bias, int lane) {
    const int hi = lane >> 5;
    f32x16 S = {0.f, 0.f, 0.f, 0.f, 0.f, 0.f, 0.f, 0.f, 0.f, 0.f, 0.f, 0.f, 0.f, 0.f, 0.f, 0.f};
#pragma unroll
    for (int s = 0; s < 4; ++s) S = MFMA32(kf[s], qf[s], S);
    float mt = -INFINITY;
#pragma unroll
    for (int r = 0; r < 16; ++r) { S[r] = S[r] * C1 + bias[r]; mt = fmaxf(mt, S[r]); }
    mt = fmaxf(mt, __shfl_xor(mt, 32));
    const float mn = fmaxf(fmaxf(m, mt), -3.0e38f);
    const float sc = fast_exp2(m - mn);
    float ps = 0.f;
#pragma unroll
    for (int r = 0; r < 16; ++r) { S[r] = fast_exp2(S[r] - mn); ps += S[r]; }
    l = l * sc + ps; m = mn;
#pragma unroll
    for (int r = 0; r < 16; ++r) { o0[r] *= sc; o1[r] *= sc; }
    const bf16x8 pf0 = pack8(S[0], S[1], S[2], S[3], S[4], S[5], S[6], S[7]), pf1 = pack8(S[8], S[9], S[10], S[11], S[12], S[13], S[14], S[15]);
    const LAS unsigned char* vb = vst + (4 * hi + ((lane >> 2) & 3)) * VST_STRIDE + (16 * ((lane >> 4) & 1) + 4 * (lane & 3)) * 2;
    asm volatile("s_waitcnt lgkmcnt(0)" ::: "memory");
    s16x4 a, b; bf16x8 vf;
    a = vtr(vb); b = vtr(vb + 8 * VST_STRIDE); vf = (bf16x8){a[0], a[1], a[2], a[3], b[0], b[1], b[2], b[3]}; o0 = MFMA32(vf, pf0, o0);
    a = vtr(vb + 64); b = vtr(vb + 8 * VST_STRIDE + 64); vf = (bf16x8){a[0], a[1], a[2], a[3], b[0], b[1], b[2], b[3]}; o1 = MFMA32(vf, pf0, o1);
    a = vtr(vb + 16 * VST_STRIDE); b = vtr(vb + 24 * VST_STRIDE); vf = (bf16x8){a[0], a[1], a[2], a[3], b[0], b[1], b[2], b[3]}; o0 = MFMA32(vf, pf1, o0);
    a = vtr(vb + 16 * VST_STRIDE + 64); b = vtr(vb + 24 * VST_STRIDE + 64); vf = (bf16x8){a[0], a[1], a[2], a[3], b[0], b[1], b[2], b[3]}; o1 = MFMA32(vf, pf1, o1);
    asm volatile("s_waitcnt lgkmcnt(0)" ::: "memory");
}
constexpr int AT_OR = 0, AT_ORS = 136, AT_ML = 512 * AT_ORS, AT_VST = AT_ML + 4096, AT_END = AT_VST + NWAVES * VST_BYTES;
__device__ __forceinline__ void attn_prompt_unit(const Frame& F, const bf16* __restrict__ PROJ, bf16* __restrict__ MIX, int b, int h, int blk) {
    const int lane = F.lane, q = lane & 31, hi = lane >> 5;
    LAS unsigned char* vst = F.lds + AT_VST + F.wave * VST_BYTES;
    const float slope2 = fast_exp2(-(float)(h + 1)) * LOG2E;
    const size_t rb = (size_t)b * SEQ;
#pragma unroll 1
    for (int br = 0; br < 3; ++br) {
        const int dil = 1 << (2 * br);
#pragma unroll 1
        for (int j2 = 0; j2 < 2; ++j2) {
            const int qt = F.wave * 2 + j2;
            int r, i0;
            if (br == 0) { r = 0; i0 = qt * 32; } else if (br == 1) { r = qt >> 2; i0 = (qt & 3) * 32; } else { r = qt; i0 = 0; }
            const int qloc = r + dil * (i0 + q);
            const bf16* qp = PROJ + (rb + blk * 512 + qloc) * NPROJ + CQ + h * HD + 8 * hi;
            bf16x8 qf[4];
#pragma unroll
            for (int s = 0; s < 4; ++s) qf[s] = *(const bf16x8*)(qp + 16 * s);
            float m, l; f32x16 o0, o1;
            LAS unsigned char* orow = F.lds + AT_OR + qloc * AT_ORS + 8 * hi;
            LAS float* ml = (LAS float*)(F.lds + AT_ML) + 2 * qloc;
            if (br == 0) { m = -INFINITY; l = 0.f;
#pragma unroll
                for (int k = 0; k < 16; ++k) { o0[k] = 0.f; o1[k] = 0.f; } }
            else { m = ml[0]; l = hi ? 0.f : ml[1];
#pragma unroll
                for (int g = 0; g < 4; ++g) { const v2u w0 = *(const LAS v2u*)(orow + 16 * g), w1 = *(const LAS v2u*)(orow + 64 + 16 * g);
                    o0[4 * g] = bflo(w0.x); o0[4 * g + 1] = bfhi(w0.x); o0[4 * g + 2] = bflo(w0.y); o0[4 * g + 3] = bfhi(w0.y);
                    o1[4 * g] = bflo(w1.x); o1[4 * g + 1] = bfhi(w1.x); o1[4 * g + 2] = bflo(w1.y); o1[4 * g + 3] = bfhi(w1.y); } }
            const int gq0 = (blk * 512) / dil + i0;
#pragma unroll 1
            for (int jt = 0; jt < 5; ++jt) {
                const int gk0 = gq0 - 128 + 32 * jt;
                if (gk0 < 0) continue;
                const bf16* kp = PROJ + (rb + r + (size_t)dil * (gk0 + q)) * NPROJ + CK + h * HD + 8 * hi;
                bf16x8 kf[4];
#pragma unroll
                for (int s = 0; s < 4; ++s) kf[s] = *(const bf16x8*)(kp + 16 * s);
                const bf16* vp = PROJ + (rb + r + (size_t)dil * (gk0 + (lane >> 1))) * NPROJ + CV + h * HD + 32 * (lane & 1);
                v4u vv[4];
#pragma unroll
                for (int s = 0; s < 4; ++s) vv[s] = *(const v4u*)(vp + 8 * s);
                LAS unsigned char* vw = vst + (lane >> 1) * VST_STRIDE + 64 * (lane & 1);
#pragma unroll
                for (int s = 0; s < 4; ++s) *(LAS v4u*)(vw + 16 * s) = vv[s];
                f32x16 bias; const float sd = slope2 * (float)dil;
#pragma unroll
                for (int rr = 0; rr < 16; ++rr) { const int kvj = crow(rr, hi); const int delta = 128 - 32 * jt + q - kvj;
                    const bool valid = (jt == 0) ? (kvj >= q) : ((jt == 4) ? (kvj <= q) : true);
                    bias[rr] = valid ? -sd * (float)delta : -INFINITY; }
                attn_tile_core(m, l, o0, o1, qf, kf, vst, bias, lane);
            }
            l += __shfl_xor(l, 32);
            if (br < 2) {
                if (hi == 0) { ml[0] = m; ml[1] = l; }
#pragma unroll
                for (int g = 0; g < 4; ++g) { v2u w0, w1; w0.x = pk2(o0[4 * g], o0[4 * g + 1]); w0.y = pk2(o0[4 * g + 2], o0[4 * g + 3]); w1.x = pk2(o1[4 * g], o1[4 * g + 1]); w1.y = pk2(o1[4 * g + 2], o1[4 * g + 3]);
                    *(LAS v2u*)(orow + 16 * g) = w0; *(LAS v2u*)(orow + 64 + 16 * g) = w1; }
            } else {
                const float inv = 1.0f / l;
                bf16* op = MIX + (rb + blk * 512 + qloc) * DM + h * HD + 4 * hi;
#pragma unroll
                for (int g = 0; g < 4; ++g) { v2u w0, w1; w0.x = pk2(o0[4 * g] * inv, o0[4 * g + 1] * inv); w0.y = pk2(o0[4 * g + 2] * inv, o0[4 * g + 3] * inv);
                    w1.x = pk2(o1[4 * g] * inv, o1[4 * g + 1] * inv); w1.y = pk2(o1[4 * g + 2] * inv, o1[4 * g + 3] * inv);
                    *(v2u*)(op + 8 * g) = w0; *(v2u*)(op + 32 + 8 * g) = w1; }
            }
        }
        __syncthreads();
    }
}
constexpr int AS_MRG = NWAVES * VST_BYTES;
__device__ __forceinline__ int as_pos(int t, int j) { return t < 24 ? 16 * (4 * t + (j >> 3)) + (j & 7) : (t < 40 ? 1536 + 32 * (t - 24) + j : WBUF + j); }
__device__ __forceinline__ void attn_sample_task(const Frame& F, const bf16* __restrict__ PROJ, const float* __restrict__ cache_k, const float* __restrict__ cache_v, bf16* __restrict__ MIX, int n, int h, int half, int pair) {
    const int lane = F.lane, q = lane & 31, hi = lane >> 5, qi = q & 7;
    LAS unsigned char* vst = F.lds + F.wave * VST_BYTES;
    const float slope2 = fast_exp2(-(float)(h + 1)) * LOG2E;
    const bf16* qp = PROJ + (size_t)(MP + n * DECT + qi) * NPROJ + CQ + h * HD + 8 * hi;
    bf16x8 qf[4];
#pragma unroll
    for (int s = 0; s < 4; ++s) qf[s] = *(const bf16x8*)(qp + 16 * s);
    float m = -INFINITY, l = 0.f; f32x16 o0, o1;
#pragma unroll
    for (int k = 0; k < 16; ++k) { o0[k] = 0.f; o1[k] = 0.f; }
    const int t0 = half ? 21 : 0, t1 = half ? 41 : 21;
#pragma unroll 1
    for (int t = t0; t < t1; ++t) {
        bf16x8 kf[4];
        LAS unsigned char* vw = vst + (lane >> 1) * VST_STRIDE + 64 * (lane & 1);
        if (t < 40) {
            const int pk = as_pos(t, q), pv = as_pos(t, lane >> 1);
            const float* kp = cache_k + (((size_t)n * WBUF + pk) * NH + h) * HD + 8 * hi;
            const float* vp = cache_v + (((size_t)n * WBUF + pv) * NH + h) * HD + 32 * (lane & 1);
            f32x4 kk[8], vv[8];
#pragma unroll
            for (int s = 0; s < 4; ++s) { kk[2 * s] = *(const f32x4*)(kp + 16 * s); kk[2 * s + 1] = *(const f32x4*)(kp + 16 * s + 4); }
#pragma unroll
            for (int s = 0; s < 8; ++s) vv[s] = *(const f32x4*)(vp + 4 * s);
#pragma unroll
            for (int s = 0; s < 4; ++s) kf[s] = cvt8(kk[2 * s], kk[2 * s + 1]);
#pragma unroll
            for (int s = 0; s < 4; ++s) *(LAS bf16x8*)(vw + 16 * s) = cvt8(vv[2 * s], vv[2 * s + 1]);
        } else {
            const bf16* kp = PROJ + (size_t)(MP + n * DECT + (q & 7)) * NPROJ + CK + h * HD + 8 * hi;
            const bf16* vp = PROJ + (size_t)(MP + n * DECT + ((lane >> 1) & 7)) * NPROJ + CV + h * HD + 32 * (lane & 1);
#pragma unroll
            for (int s = 0; s < 4; ++s) kf[s] = *(const bf16x8*)(kp + 16 * s);
#pragma unroll
            for (int s = 0; s < 4; ++s) *(LAS v4u*)(vw + 16 * s) = *(const v4u*)(vp + 8 * s);
        }
        f32x16 bias;
#pragma unroll
        for (int rr = 0; rr < 16; ++rr) { const int p = as_pos(t, crow(rr, hi)); const int d = WBUF + qi - p;
            const int mult = (d >= 0) ? ((d <= 128 ? 1 : 0) + (((d & 3) == 0 && d <= 512) ? 1 : 0) + (((d & 15) == 0 && d <= 2048) ? 1 : 0)) : 0;
            const float lm = (mult == 3) ? 1.5849625007211562f : ((mult == 2) ? 1.0f : 0.0f);
            bias[rr] = mult ? (lm - slope2 * (float)d) : -INFINITY; }
        attn_tile_core(m, l, o0, o1, qf, kf, vst, bias, lane);
    }
    l += __shfl_xor(l, 32);
    LAS float* mg = (LAS float*)(F.lds + AS_MRG) + pair * 34 * 64 + lane;
    if (half) { mg[0] = m; mg[64] = l;
#pragma unroll
        for (int k = 0; k < 16; ++k) { mg[(2 + k) * 64] = o0[k]; mg[(18 + k) * 64] = o1[k]; } }
    __syncthreads();
    if (!half) {
        const float m2 = mg[0], l2 = mg[64]; const float mn = fmaxf(fmaxf(m, m2), -3.0e38f); const float a = fast_exp2(m - mn), c = fast_exp2(m2 - mn);
        const float inv = 1.0f / (l * a + l2 * c);
#pragma unroll
        for (int k = 0; k < 16; ++k) { o0[k] = (o0[k] * a + mg[(2 + k) * 64] * c) * inv; o1[k] = (o1[k] * a + mg[(18 + k) * 64] * c) * inv; }
        if (q < 8) { bf16* op = MIX + (size_t)(MP + n * DECT + q) * DM + h * HD + 4 * hi;
#pragma unroll
            for (int g = 0; g < 4; ++g) { v2u w0, w1; w0.x = pk2(o0[4 * g], o0[4 * g + 1]); w0.y = pk2(o0[4 * g + 2], o0[4 * g + 3]); w1.x = pk2(o1[4 * g], o1[4 * g + 1]); w1.y = pk2(o1[4 * g + 2], o1[4 * g + 3]);
                *(v2u*)(op + 8 * g) = w0; *(v2u*)(op + 32 + 8 * g) = w1; } }
    }
    __syncthreads();
}
constexpr int SROW = 272;
__device__ __forceinline__ float softplusf_(float x) { return x > 20.f ? x : log1pf(__expf(x)); }
__device__ __forceinline__ void ssd_dt_scan(const Frame& F, CArgs A, const float* __restrict__ DT, int row0, int g, LAS float* acs, LAS float* dtv, LAS float* atl) {
    if (F.wave < 4) {
        const int hh = F.wave, h = 4 * g + hh, lane = F.lane;
        const float dtb = A->in[I_DTB][h], a = -__expf(A->in[I_ALOG][h]);
        const float d0 = softplusf_(DT[(size_t)(row0 + lane) * 8 + h] + dtb), d1 = softplusf_(DT[(size_t)(row0 + 64 + lane) * 8 + h] + dtb);
        float c0 = d0 * a, c1 = d1 * a;
#pragma unroll
        for (int o = 1; o < 64; o <<= 1) { const float t0 = __shfl_up(c0, o), t1 = __shfl_up(c1, o); if (lane >= o) { c0 += t0; c1 += t1; } }
        c1 += __shfl(c0, 63);
        acs[hh * 128 + lane] = c0; acs[hh * 128 + 64 + lane] = c1; dtv[hh * 128 + lane] = d0; dtv[hh * 128 + 64 + lane] = d1;
        if (lane == 63) atl[hh] = c1;
    }
}
struct Conv8 { f32x4 w[4][2]; f32x4 b[2]; };
__device__ __forceinline__ void conv8_load(Conv8& c, const float* __restrict__ cw, const float* __restrict__ cb, int cidx) {
#pragma unroll
    for (int w = 0; w < 4; ++w) { c.w[w][0] = *(const f32x4*)(cw + w * CONVD + cidx); c.w[w][1] = *(const f32x4*)(cw + w * CONVD + cidx + 4); }
    c.b[0] = *(const f32x4*)(cb + cidx); c.b[1] = *(const f32x4*)(cb + cidx + 4);
}
struct Row8 { f32x4 a, b; };
__device__ __forceinline__ Row8 row8_from(const v4u r) { Row8 o; o.a = (f32x4){bflo(r.x), bfhi(r.x), bflo(r.y), bfhi(r.y)}; o.b = (f32x4){bflo(r.z), bfhi(r.z), bflo(r.w), bfhi(r.w)}; return o; }
__device__ __forceinline__ Row8 conv8_silu(const Conv8& c, const Row8& x3, const Row8& x2, const Row8& x1, const Row8& x0) {
    Row8 o; o.a = c.b[0] + c.w[0][0] * x3.a + c.w[1][0] * x2.a + c.w[2][0] * x1.a + c.w[3][0] * x0.a; o.b = c.b[1] + c.w[0][1] * x3.b + c.w[1][1] * x2.b + c.w[2][1] * x1.b + c.w[3][1] * x0.b;
#pragma unroll
    for (int k = 0; k < 4; ++k) { o.a[k] = siluf_(o.a[k]); o.b[k] = siluf_(o.b[k]); }
    return o;
}
constexpr int SS_XT = 0, SS_B = 256 * SROW, SS_C = SS_B + 128 * SROW, SS_ACS = SS_C + 128 * SROW, SS_DTV = SS_ACS + 2048, SS_ATL = SS_DTV + 2048, SS_SS = SS_ATL + 128, SS_END = SS_SS + 2048;
static_assert(SS_END <= RING_BYTES, "SSD LDS map");
__device__ __forceinline__ void ssd_states_unit(const Frame& F, CArgs A, int b, int c, int g) {
    unsigned char* ws = A->ws; const bf16* __restrict__ PROJ = (const bf16*)(ws + WS_PROJ); const float* DT = (const float*)(ws + WS_DT);
    float* STLOC = (float*)(ws + WS_STLOC); float* ATOT = (float*)(ws + WS_ATOT);
    const int row0 = b * SEQ + c * 128, lane = F.lane, hi = lane >> 5;
    LAS float* acs = (LAS float*)(F.lds + SS_ACS); LAS float* dtv = (LAS float*)(F.lds + SS_DTV); LAS float* atl = (LAS float*)(F.lds + SS_ATL);
    ssd_dt_scan(F, A, DT, row0, g, acs, dtv, atl);
    __syncthreads();
    if (F.tid < 384) {
        const int cg = F.tid % 48, lseg = F.tid / 48; const bool isx = cg < 32; const int hh = cg >> 3;
        const int cidx = isx ? g * 256 + cg * 8 : 512 + g * 128 + (cg - 32) * 8;
        Conv8 cv; conv8_load(cv, A->in[I_CONVW], A->in[I_CONVB], cidx);
        const int l0 = 16 * lseg; const bf16* src = PROJ + (size_t)row0 * NPROJ + CXB + cidx;
        const Row8 zero = {(f32x4){0.f, 0.f, 0.f, 0.f}, (f32x4){0.f, 0.f, 0.f, 0.f}};
        Row8 x3 = (c * 128 + l0 - 3 >= 0) ? row8_from(*(const v4u*)(src + (ptrdiff_t)(l0 - 3) * NPROJ)) : zero;
        Row8 x2 = (c * 128 + l0 - 2 >= 0) ? row8_from(*(const v4u*)(src + (ptrdiff_t)(l0 - 2) * NPROJ)) : zero;
        Row8 x1 = (c * 128 + l0 - 1 >= 0) ? row8_from(*(const v4u*)(src + (ptrdiff_t)(l0 - 1) * NPROJ)) : zero;
        LAS unsigned char* dst = F.lds + (isx ? SS_XT + (cg * 8) * SROW : SS_B + ((cg - 32) * 8) * SROW);
        const float at = isx ? atl[hh] : 0.f;
#pragma unroll 4
        for (int li = 0; li < 16; ++li) { const int l = l0 + li;
            const Row8 x0 = row8_from(*(const v4u*)(src + (size_t)l * NPROJ));
            Row8 s = conv8_silu(cv, x3, x2, x1, x0);
            if (isx) { const float f = dtv[hh * 128 + l] * __expf(at - acs[hh * 128 + l]); s.a = s.a * f; s.b = s.b * f; }
#pragma unroll
            for (int k = 0; k < 4; ++k) { *(LAS unsigned short*)(dst + k * SROW + 2 * l) = (unsigned short)f2bf(s.a[k]); *(LAS unsigned short*)(dst + (4 + k) * SROW + 2 * l) = (unsigned short)f2bf(s.b[k]); }
            x3 = x2; x2 = x1; x1 = x0; }
    }
    __syncthreads();
    {
        const int hh = F.wave >> 1, ph = F.wave & 1, h = 4 * g + hh;
        f32x16 acc[4];
#pragma unroll
        for (int nt = 0; nt < 4; ++nt)
#pragma unroll
            for (int k = 0; k < 16; ++k) acc[nt][k] = 0.f;
        const LAS unsigned char* ar = F.lds + SS_XT + (hh * 64 + 32 * ph + (lane & 31)) * SROW + 16 * hi;
        const LAS unsigned char* brw = F.lds + SS_B + (lane & 31) * SROW + 16 * hi;
#pragma unroll
        for (int ks = 0; ks < 8; ++ks) { const bf16x8 af = *(const LAS bf16x8*)(ar + 32 * ks);
#pragma unroll
            for (int nt = 0; nt < 4; ++nt) { const bf16x8 bf = *(const LAS bf16x8*)(brw + nt * 32 * SROW + 32 * ks); acc[nt] = MFMA32(af, bf, acc[nt]); } }
        float* o = STLOC + ((size_t)((b * 16 + c) * NH + h) * HD + 32 * ph) * DST + (lane & 31);
#pragma unroll
        for (int nt = 0; nt < 4; ++nt)
#pragma unroll
            for (int k = 0; k < 16; ++k) o[(size_t)crow(k, hi) * DST + 32 * nt] = acc[nt][k];
        if (lane == 0 && ph == 0) ATOT[(b * 16 + c) * NH + h] = atl[hh];
    }
    __syncthreads();
}
__device__ __forceinline__ void ssd_scan_unit(const Frame& F, CArgs A, int unit) {
    const int bh = unit >> 2, pq = unit & 3, b = bh >> 3, h = bh & 7;
    float* STLOC = (float*)(A->ws + WS_STLOC); const float* ATOT = (const float*)(A->ws + WS_ATOT);
    const int p = 16 * pq + (F.tid >> 5), n4 = (F.tid & 31) * 4;
    f32x4 s = {0.f, 0.f, 0.f, 0.f};
#pragma unroll 4
    for (int c = 0; c < 16; ++c) { f32x4* slot = (f32x4*)(STLOC + ((size_t)((b * 16 + c) * NH + h) * HD + p) * DST + n4);
        const f32x4 loc = *slot; *slot = s; s = s * __expf(ATOT[(b * 16 + c) * NH + h]) + loc; }
    *(f32x4*)(A->out + O_SP + ((size_t)(b * NH + h) * HD + p) * DST + n4) = s;
}
__device__ __forceinline__ void ssd_out_unit(const Frame& F, CArgs A, int b, int c, int g) {
    unsigned char* ws = A->ws; const bf16* __restrict__ PROJ = (const bf16*)(ws + WS_PROJ); const float* DT = (const float*)(ws + WS_DT);
    const float* STLOC = (const float*)(ws + WS_STLOC); bf16* MIX = (bf16*)(ws + WS_MIX);
    const int row0 = b * SEQ + c * 128, lane = F.lane, hi = lane >> 5;
    LAS float* acs = (LAS float*)(F.lds + SS_ACS); LAS float* dtv = (LAS float*)(F.lds + SS_DTV); LAS float* atl = (LAS float*)(F.lds + SS_ATL); LAS float* ssq = (LAS float*)(F.lds + SS_SS);
    ssd_dt_scan(F, A, DT, row0, g, acs, dtv, atl);
    {
        const int cg = F.tid & 63, lseg = F.tid >> 6; const int kind = cg < 32 ? 0 : (cg < 48 ? 1 : 2);
        const int cidx = kind == 0 ? g * 256 + cg * 8 : (kind == 1 ? 512 + g * 128 + (cg - 32) * 8 : 768 + g * 128 + (cg - 48) * 8);
        Conv8 cv; conv8_load(cv, A->in[I_CONVW], A->in[I_CONVB], cidx);
        const int l0 = 16 * lseg; const bf16* src = PROJ + (size_t)row0 * NPROJ + CXB + cidx;
        const Row8 zero = {(f32x4){0.f, 0.f, 0.f, 0.f}, (f32x4){0.f, 0.f, 0.f, 0.f}};
        Row8 x3 = (c * 128 + l0 - 3 >= 0) ? row8_from(*(const v4u*)(src + (ptrdiff_t)(l0 - 3) * NPROJ)) : zero;
        Row8 x2 = (c * 128 + l0 - 2 >= 0) ? row8_from(*(const v4u*)(src + (ptrdiff_t)(l0 - 2) * NPROJ)) : zero;
        Row8 x1 = (c * 128 + l0 - 1 >= 0) ? row8_from(*(const v4u*)(src + (ptrdiff_t)(l0 - 1) * NPROJ)) : zero;
        LAS unsigned char* dstx = F.lds + SS_XT + (cg * 8) * SROW;
        LAS unsigned char* dstn = F.lds + (kind == 1 ? SS_B + (cg - 32) * 16 : SS_C + (cg - 48) * 16);
#pragma unroll 4
        for (int li = 0; li < 16; ++li) { const int l = l0 + li;
            const Row8 x0 = row8_from(*(const v4u*)(src + (size_t)l * NPROJ));
            const Row8 s = conv8_silu(cv, x3, x2, x1, x0);
            if (kind == 0) {
#pragma unroll
                for (int k = 0; k < 4; ++k) { *(LAS unsigned short*)(dstx + k * SROW + 2 * l) = (unsigned short)f2bf(s.a[k]); *(LAS unsigned short*)(dstx + (4 + k) * SROW + 2 * l) = (unsigned short)f2bf(s.b[k]); }
            } else *(LAS bf16x8*)(dstn + l * SROW) = cvt8(s.a, s.b);
            x3 = x2; x2 = x1; x1 = x0; }
    }
    __syncthreads();
    const int hh = F.wave >> 1, lh = F.wave & 1, h = 4 * g + hh;
    f32x16 acc[2][2];
#pragma unroll
    for (int i = 0; i < 2; ++i)
#pragma unroll
        for (int j = 0; j < 2; ++j)
#pragma unroll
            for (int k = 0; k < 16; ++k) acc[i][j][k] = 0.f;
    const LAS unsigned char* cn = F.lds + SS_C + (lane & 31) * SROW + 16 * hi;
    const LAS unsigned char* bn = F.lds + SS_B + (lane & 31) * SROW + 16 * hi;
    {
        const float* sp = STLOC + ((size_t)((b * 16 + c) * NH + h) * HD + (lane & 31)) * DST + 8 * hi;
#pragma unroll 2
        for (int ks = 0; ks < 8; ++ks) {
            const bf16x8 cf0 = *(const LAS bf16x8*)(cn + (64 * lh) * SROW + 32 * ks), cf1 = *(const LAS bf16x8*)(cn + (64 * lh + 32) * SROW + 32 * ks);
#pragma unroll
            for (int pt = 0; pt < 2; ++pt) { const float* s_ = sp + (size_t)(32 * pt) * DST + 16 * ks; const bf16x8 af = cvt8(*(const f32x4*)s_, *(const f32x4*)(s_ + 4));
                acc[0][pt] = MFMA32(af, cf0, acc[0][pt]); acc[1][pt] = MFMA32(af, cf1, acc[1][pt]); } }
#pragma unroll
        for (int lt2 = 0; lt2 < 2; ++lt2) { const float e = __expf(acs[hh * 128 + 64 * lh + 32 * lt2 + (lane & 31)]);
#pragma unroll
            for (int pt = 0; pt < 2; ++pt)
#pragma unroll
                for (int k = 0; k < 16; ++k) acc[lt2][pt][k] *= e; }
    }
    const float dsk = A->in[I_DSKIP][h];
#pragma unroll
    for (int lt2 = 0; lt2 < 2; ++lt2) {
        const int lt = 2 * lh + lt2, lcol = 32 * lt + (lane & 31); const float acs_l = acs[hh * 128 + lcol];
#pragma unroll 1
        for (int st = 0; st <= lt; ++st) {
            f32x16 X;
#pragma unroll
            for (int k = 0; k < 16; ++k) X[k] = 0.f;
#pragma unroll
            for (int ks = 0; ks < 8; ++ks) { const bf16x8 bnf = *(const LAS bf16x8*)(bn + (32 * st) * SROW + 32 * ks), cnf = *(const LAS bf16x8*)(cn + (32 * lt) * SROW + 32 * ks); X = MFMA32(bnf, cnf, X); }
#pragma unroll
            for (int k = 0; k < 16; ++k) { const int s = 32 * st + crow(k, hi); const float as = acs[hh * 128 + s], dts = dtv[hh * 128 + s];
                X[k] = (s <= lcol) ? X[k] * __expf(fminf(acs_l - as, 0.f)) * dts : 0.f; }
            const bf16x8 pf0 = pack8(X[0], X[1], X[2], X[3], X[4], X[5], X[6], X[7]), pf1 = pack8(X[8], X[9], X[10], X[11], X[12], X[13], X[14], X[15]);
#pragma unroll
            for (int pt = 0; pt < 2; ++pt) { const LAS unsigned char* xr = F.lds + SS_XT + (hh * 64 + 32 * pt + (lane & 31)) * SROW + 64 * st + 8 * hi;
                v2u a0 = *(const LAS v2u*)(xr), a1 = *(const LAS v2u*)(xr + 16), b0 = *(const LAS v2u*)(xr + 32), b1 = *(const LAS v2u*)(xr + 48);
                const bf16x8 xf0 = __builtin_bit_cast(bf16x8, (v4u){a0.x, a0.y, a1.x, a1.y}), xf1 = __builtin_bit_cast(bf16x8, (v4u){b0.x, b0.y, b1.x, b1.y});
                acc[lt2][pt] = MFMA32(xf0, pf0, acc[lt2][pt]); acc[lt2][pt] = MFMA32(xf1, pf1, acc[lt2][pt]); }
        }
        float ss = 0.f;
#pragma unroll
        for (int pt = 0; pt < 2; ++pt)
#pragma unroll
            for (int rg = 0; rg < 4; ++rg) { const v2u zw = *(const v2u*)(PROJ + (size_t)(row0 + lcol) * NPROJ + CZ + h * HD + 32 * pt + 8 * rg + 4 * hi);
                const float z[4] = {bflo(zw.x), bfhi(zw.x), bflo(zw.y), bfhi(zw.y)};
#pragma unroll
                for (int e = 0; e < 4; ++e) { const int k = 4 * rg + e; const float xv = bf2f(*(const LAS unsigned short*)(F.lds + SS_XT + (hh * 64 + 32 * pt + crow(k, hi)) * SROW + 2 * lcol));
                    const float y = (acc[lt2][pt][k] + dsk * xv) * siluf_(z[e]); acc[lt2][pt][k] = y; ss += y * y; } }
        ss += __shfl_xor(ss, 32);
        if (hi == 0) ssq[hh * 128 + lcol] = ss;
    }
    __syncthreads();
#pragma unroll
    for (int lt2 = 0; lt2 < 2; ++lt2) {
        const int lcol = 32 * (2 * lh + lt2) + (lane & 31);
        const float tot = (ssq[lcol] + ssq[128 + lcol]) + (ssq[256 + lcol] + ssq[384 + lcol]); const float rstd = 1.0f / sqrtf(tot * (1.0f / 256.0f) + LN_EPS);
#pragma unroll
        for (int pt = 0; pt < 2; ++pt)
#pragma unroll
            for (int rg = 0; rg < 4; ++rg) { const int ch = h * HD + 32 * pt + 8 * rg + 4 * hi; const f32x4 nw = *(const f32x4*)(A->in[I_NORMW] + ch);
                v2u w; w.x = pk2(acc[lt2][pt][4 * rg] * rstd * nw[0], acc[lt2][pt][4 * rg + 1] * rstd * nw[1]); w.y = pk2(acc[lt2][pt][4 * rg + 2] * rstd * nw[2], acc[lt2][pt][4 * rg + 3] * rstd * nw[3]);
                *(v2u*)(MIX + (size_t)(row0 + lcol) * DM + 512 + ch) = w; }
    }
    __syncthreads();
}
constexpr int SP_XS = 0, SP_BS = 8192, SP_CS = 12288, SP_DTS = 16384, SP_ACS = 16512, SP_CB = 16640, SP_YOFF = 16896, SP_YV = 25088, SP_END = 33280;
__device__ __forceinline__ void ssd_sample_unit(const Frame& F, CArgs A, int n, int g) {
    unsigned char* ws = A->ws; const bf16* __restrict__ PROJ = (const bf16*)(ws + WS_PROJ); const float* DT = (const float*)(ws + WS_DT); bf16* MIX = (bf16*)(ws + WS_MIX);
    LAS float* XS = (LAS float*)(F.lds + SP_XS); LAS float* BS = (LAS float*)(F.lds + SP_BS); LAS float* CS_ = (LAS float*)(F.lds + SP_CS); LAS float* DTS = (LAS float*)(F.lds + SP_DTS);
    LAS float* ACS = (LAS float*)(F.lds + SP_ACS); LAS float* CB = (LAS float*)(F.lds + SP_CB); LAS float* YOFF = (LAS float*)(F.lds + SP_YOFF); LAS float* YV = (LAS float*)(F.lds + SP_YV);
    const int tid = F.tid, lane = F.lane; const int rowb = MP + n * DECT;
    {
        const int kind = tid < 256 ? 0 : (tid < 384 ? 1 : 2);
        const int cidx = kind == 0 ? g * 256 + tid : (kind == 1 ? 512 + g * 128 + (tid - 256) : 768 + g * 128 + (tid - 384));
        const float* cw = A->in[I_CONVW]; const float w0 = cw[cidx], w1 = cw[CONVD + cidx], w2 = cw[2 * CONVD + cidx], w3 = cw[3 * CONVD + cidx], cb = A->in[I_CONVB][cidx];
        const float* sc = A->in[I_SCONV] + (size_t)n * 3 * CONVD + cidx;
        float x3 = sc[0], x2 = sc[CONVD], x1 = sc[2 * CONVD];
        LAS float* dst = kind == 0 ? XS + tid : (kind == 1 ? BS + (tid - 256) : CS_ + (tid - 384)); const int dstride = kind == 0 ? 256 : 128;
#pragma unroll
        for (int l = 0; l < DECT; ++l) { const float x0 = bf2f(PROJ[(size_t)(rowb + l) * NPROJ + CXB + cidx]);
            dst[l * dstride] = siluf_(cb + w0 * x3 + w1 * x2 + w2 * x1 + w3 * x0);
            if (l >= DECT - 3) A->out[O_CS + ((size_t)n * 3 + (l - (DECT - 3))) * CONVD + cidx] = x0;
            x3 = x2; x2 = x1; x1 = x0; }
        if (tid < 4) { const int h = 4 * g + tid; const float dtb = A->in[I_DTB][h], a = -__expf(A->in[I_ALOG][h]); float cum = 0.f;
#pragma unroll
            for (int l = 0; l < DECT; ++l) { const float d = softplusf_(DT[(size_t)(rowb + l) * 8 + h] + dtb); cum += d * a; DTS[tid * 8 + l] = d; ACS[tid * 8 + l] = cum; } }
    }
    __syncthreads();
    if (F.wave == 0) {
        const int l = lane >> 3, s = lane & 7; float d = 0.f;
#pragma unroll 8
        for (int k = 0; k < DST; ++k) d += CS_[l * 128 + k] * BS[s * 128 + k];
        CB[lane] = d;
    }
    {
        const int hh = F.wave >> 1, ph = F.wave & 1, h = 4 * g + hh, n4 = (lane & 31) * 4, pr = 32 * ph + (lane >> 5);
        const float* h0 = A->in[I_SSSM] + ((size_t)(n * NH + h) * HD + pr) * DST + n4;
        f32x4 H[16], S[16];
#pragma unroll
        for (int k = 0; k < 16; ++k) { H[k] = *(const f32x4*)(h0 + (size_t)(2 * k) * DST); S[k] = (f32x4){0.f, 0.f, 0.f, 0.f}; }
        const float aT = ACS[hh * 8 + 7];
#pragma unroll 1
        for (int l = 0; l < DECT; ++l) {
            const f32x4 c4 = *(const LAS f32x4*)(CS_ + l * 128 + n4), b4 = *(const LAS f32x4*)(BS + l * 128 + n4);
            const float al = ACS[hh * 8 + l], el = __expf(al), f = __expf(aT - al) * DTS[hh * 8 + l];
#pragma unroll
            for (int k = 0; k < 16; ++k) { float d = (c4[0] * H[k][0] + c4[1] * H[k][1]) + (c4[2] * H[k][2] + c4[3] * H[k][3]);
                d += __shfl_xor(d, 1); d += __shfl_xor(d, 2); d += __shfl_xor(d, 4); d += __shfl_xor(d, 8); d += __shfl_xor(d, 16);
                const int p = pr + 2 * k;
                if ((lane & 31) == 0) YOFF[l * 256 + hh * 64 + p] = d * el;
                const float xf = XS[l * 256 + hh * 64 + p] * f; S[k] = S[k] + b4 * xf; }
        }
        const float eT = __expf(aT);
        float* so = A->out + O_SS + ((size_t)(n * NH + h) * HD + pr) * DST + n4;
#pragma unroll
        for (int k = 0; k < 16; ++k) *(f32x4*)(so + (size_t)(2 * k) * DST) = H[k] * eT + S[k];
    }
    __syncthreads();
#pragma unroll
    for (int e = 0; e < 4; ++e) { const int idx = tid + 512 * e, l = idx >> 8, ch = idx & 255, hh = ch >> 6, h = 4 * g + hh;
        float y = YOFF[idx] + A->in[I_DSKIP][h] * XS[idx]; const float al = ACS[hh * 8 + l];
        for (int s = 0; s <= l; ++s) y += CB[l * 8 + s] * __expf(al - ACS[hh * 8 + s]) * DTS[hh * 8 + s] * XS[s * 256 + ch];
        const float z = bf2f(PROJ[(size_t)(rowb + l) * NPROJ + CZ + g * 256 + ch]);
        YV[idx] = y * siluf_(z); }
    __syncthreads();
    {
        const int l = F.wave; const f32x4 v = *(const LAS f32x4*)(YV + l * 256 + 4 * lane);
        const float ss = wave_sum((v[0] * v[0] + v[1] * v[1]) + (v[2] * v[2] + v[3] * v[3])); const float rstd = 1.0f / sqrtf(ss * (1.0f / 256.0f) + LN_EPS);
        const f32x4 nw = *(const f32x4*)(A->in[I_NORMW] + g * 256 + 4 * lane);
        v2u w; w.x = pk2(v[0] * rstd * nw[0], v[1] * rstd * nw[1]); w.y = pk2(v[2] * rstd * nw[2], v[3] * rstd * nw[3]);
        *(v2u*)(MIX + (size_t)(rowb + l) * DM + 512 + g * 256 + 4 * lane) = w;
    }
    __syncthreads();
}
template <int NB, class Epi>
__device__ __forceinline__ void small_gemm_unit(const Frame& F, const bf16* __restrict__ A, const bf16* __restrict__ Bt, int K, int row0, int col0, const Epi& E) {
    constexpr int KS = 8 / NB;
    const int lane = F.lane, r = lane & 15, q = lane >> 4, nb = F.wave % NB, ks = F.wave / NB;
    const int kw = K / KS;
    f32x4 acc[4][4];
#pragma unroll
    for (int i = 0; i < 4; ++i)
#pragma unroll
        for (int j = 0; j < 4; ++j) acc[i][j] = (f32x4){0.f, 0.f, 0.f, 0.f};
    const bf16* ap = A + (size_t)(row0 + r) * K + ks * kw + 8 * q;
    const bf16* bp = Bt + (size_t)(col0 + nb * 64 + r) * K + ks * kw + 8 * q;
    const size_t k16 = (size_t)16 * K;
#pragma unroll 4
    for (int kk = 0; kk < kw; kk += 32) {
        bf16x8 a[4], b[4];
#pragma unroll
        for (int i = 0; i < 4; ++i) { a[i] = *(const bf16x8*)(ap + i * k16 + kk); b[i] = *(const bf16x8*)(bp + i * k16 + kk); }
#pragma unroll
        for (int i = 0; i < 4; ++i)
#pragma unroll
            for (int j = 0; j < 4; ++j) acc[i][j] = __builtin_amdgcn_mfma_f32_16x16x32_bf16(a[i], b[j], acc[i][j], 0, 0, 0);
    }
    LAS float* part = (LAS float*)F.lds + (ks * NB + nb) * 4096;
#pragma unroll
    for (int i = 0; i < 4; ++i)
#pragma unroll
        for (int j = 0; j < 4; ++j)
#pragma unroll
            for (int k = 0; k < 4; ++k) part[(16 * i + 4 * q + k) * 64 + 16 * j + r] = acc[i][j][k];
    __syncthreads();
    {
        const int row = F.tid >> 3, c8 = (F.tid & 7) * 8; float s = 0.f, s2 = 0.f;
#pragma unroll
        for (int n = 0; n < NB; ++n) {
            f32x4 a = {0.f, 0.f, 0.f, 0.f}, b = {0.f, 0.f, 0.f, 0.f};
#pragma unroll
            for (int k = 0; k < KS; ++k) { const LAS float* p = (const LAS float*)F.lds + (k * NB + n) * 4096 + row * 64 + c8; a = a + *(const LAS f32x4*)p; b = b + *(const LAS f32x4*)(p + 4); }
            E.row8(row0 + row, col0 + n * 64 + c8, a, b, s, s2);
        }
        if (Epi::STATS) { s += __shfl_xor(s, 1); s += __shfl_xor(s, 2); s += __shfl_xor(s, 4); s2 += __shfl_xor(s2, 1); s2 += __shfl_xor(s2, 2); s2 += __shfl_xor(s2, 4);
            if ((F.tid & 7) == 0) E.flush(row0 + row, s, s2); }
    }
    __syncthreads();
}
__device__ __forceinline__ void unpack8f(const v4u w, f32x4& x0, f32x4& x1) { x0 = (f32x4){bflo(w.x), bfhi(w.x), bflo(w.y), bfhi(w.y)}; x1 = (f32x4){bflo(w.z), bfhi(w.z), bflo(w.w), bfhi(w.w)}; }
__device__ __forceinline__ void sums8(const f32x4 a, const f32x4 b, float& s, float& s2) {
    s += (a[0] + a[1]) + (a[2] + a[3]) + (b[0] + b[1]) + (b[2] + b[3]);
    s2 += (a[0] * a[0] + a[1] * a[1]) + (a[2] * a[2] + a[3] * a[3]) + (b[0] * b[0] + b[1] * b[1]) + (b[2] * b[2] + b[3] * b[3]); }
struct RowProj { static constexpr bool STATS = false; bf16* P; float* out;
    __device__ __forceinline__ void row8(int row, int col, f32x4 a, f32x4 b, float&, float&) const {
        *(v4u*)(P + (size_t)row * NPROJ + col) = pack_acc8(a, b);
        if (col >= CK && col < CZ) { const bool isv = col >= CV; float* o = out + (isv ? O_VS : O_KS) + (size_t)(row - MP) * 512 + (col - (isv ? CV : CK)); *(f32x4*)o = a; *(f32x4*)(o + 4) = b; } }
    __device__ __forceinline__ void flush(int, float, float) const {} };
struct RowOut { static constexpr bool STATS = true; const bf16* H0; bf16* V1; float* ST;
    __device__ __forceinline__ void row8(int row, int col, f32x4 a, f32x4 b, float& s, float& s2) const {
        const size_t off = (size_t)row * DM + col; f32x4 x0, x1; unpack8f(*(const v4u*)(H0 + off), x0, x1); a = a + ALPHA * x0; b = b + ALPHA * x1; sums8(a, b, s, s2); *(v4u*)(V1 + off) = pack_acc8(a, b); }
    __device__ __forceinline__ void flush(int row, float s, float s2) const { unsafeAtomicAdd(ST + 2 * row, s); unsafeAtomicAdd(ST + 2 * row + 1, s2); } };
struct RowUp { static constexpr bool STATS = false; bf16* U; const float* ST; const float* cs; const float* bw;
    __device__ __forceinline__ void row8(int row, int col, f32x4 a, f32x4 b, float&, float&) const {
        float mu, rs; row_stats(ST[2 * row], ST[2 * row + 1], mu, rs);
        a = (a - mu * *(const f32x4*)(cs + col)) * rs + *(const f32x4*)(bw + col); b = (b - mu * *(const f32x4*)(cs + col + 4)) * rs + *(const f32x4*)(bw + col + 4);
#pragma unroll
        for (int k = 0; k < 4; ++k) { a[k] = fmaxf(a[k], 0.f); a[k] *= a[k]; b[k] = fmaxf(b[k], 0.f); b[k] *= b[k]; }
        *(v4u*)(U + (size_t)row * DFF + col) = pack_acc8(a, b); }
    __device__ __forceinline__ void flush(int, float, float) const {} };
struct RowDown { static constexpr bool STATS = true; const bf16* V1; bf16* V2; const float* ST1; float* ST2; const float* g; const float* bb;
    __device__ __forceinline__ void row8(int row, int col, f32x4 a, f32x4 b, float& s, float& s2) const {
        float mu, rs; row_stats(ST1[2 * row], ST1[2 * row + 1], mu, rs); const size_t off = (size_t)row * DM + col; f32x4 x0, x1; unpack8f(*(const v4u*)(V1 + off), x0, x1);
        a = a + ALPHA * ((x0 - mu) * rs * *(const f32x4*)(g + col) + *(const f32x4*)(bb + col)); b = b + ALPHA * ((x1 - mu) * rs * *(const f32x4*)(g + col + 4) + *(const f32x4*)(bb + col + 4));
        sums8(a, b, s, s2); *(v4u*)(V2 + off) = pack_acc8(a, b); }
    __device__ __forceinline__ void flush(int row, float s, float s2) const { unsafeAtomicAdd(ST2 + 2 * row, s); unsafeAtomicAdd(ST2 + 2 * row + 1, s2); } };
struct RowPle { static constexpr bool STATS = false; bf16* O;
    __device__ __forceinline__ void row8(int row, int col, f32x4 a, f32x4 b, float&, float&) const { *(v4u*)(O + (size_t)row * DM + col) = pack_acc8(a, b); }
    __device__ __forceinline__ void flush(int, float, float) const {} };
struct RowGate { static constexpr bool STATS = false; const bf16* V2; const bf16* PLE; float* Y; const float* ST2; const float* cs; const float* bw; const float* g; const float* bb;
    __device__ __forceinline__ void row8(int row, int col, f32x4 a, f32x4 b, float&, float&) const {
        float mu, rs; row_stats(ST2[2 * row], ST2[2 * row + 1], mu, rs); const size_t off = (size_t)row * DM + col; f32x4 x0, x1, p0, p1; unpack8f(*(const v4u*)(V2 + off), x0, x1); unpack8f(*(const v4u*)(PLE + off), p0, p1);
        a = (a - mu * *(const f32x4*)(cs + col)) * rs + *(const f32x4*)(bw + col); b = (b - mu * *(const f32x4*)(cs + col + 4)) * rs + *(const f32x4*)(bw + col + 4);
#pragma unroll
        for (int k = 0; k < 4; ++k) { a[k] = sigmoidf_(a[k]); b[k] = sigmoidf_(b[k]); }
        *(f32x4*)(Y + off) = ALPHA * ((x0 - mu) * rs * *(const f32x4*)(g + col) + *(const f32x4*)(bb + col)) + a * p0;
        *(f32x4*)(Y + off + 4) = ALPHA * ((x1 - mu) * rs * *(const f32x4*)(g + col + 4) + *(const f32x4*)(bb + col + 4)) + b * p1; }
    __device__ __forceinline__ void flush(int, float, float) const {} };
constexpr int NPH = 10;
#ifndef REP_SG
#define REP_SG 1
#endif
#ifndef REP_AP
#define REP_AP 1
#endif
#ifndef REP_AS
#define REP_AS 1
#endif
#ifndef REP_SS
#define REP_SS 1
#endif
#ifndef REP_SO
#define REP_SO 1
#endif
#ifndef MK_ONE_LAUNCH
#define MK_ONE_LAUNCH 1
#endif
__global__ void __launch_bounds__(NWAVES * 64, 2) fwd_kernel(Args args_by_value) {
    extern __shared__ __attribute__((aligned(16))) unsigned char lds[];
    (void)args_by_value;
    const CArgs KA = (CArgs)__builtin_amdgcn_kernarg_segment_ptr();
#define ARGS_NOW(nm) CArgs nm = KA; asm volatile("" : "+s"(nm))
    Frame F;
    F.lds = (LAS unsigned char*)lds;
    F.MISC = (volatile LAS unsigned*)(F.lds + MISC_OFF);
    F.tid = threadIdx.x; F.lane = F.tid & 63; F.wave = __builtin_amdgcn_readfirstlane(F.tid >> 6);
    F.G = gridDim.x; { const int bx = blockIdx.x; F.vcu = (F.G % 8 == 0) ? (bx % 8) * (F.G / 8) + bx / 8 : bx; }
    F.ctl = (gu32*)(KA->ws + WS_CTL);
    for (int u = F.tid; u < (LDS_BYTES - LDSCTL_OFF) / 4; u += NWAVES * 64) ((LAS unsigned*)(F.lds + LDSCTL_OFF))[u] = 0u;
    __syncthreads();
    const int lo = KA->ph_lo, hi = KA->ph_hi;
    XcdBarrier bar; bar.bar = (unsigned*)(F.ctl + CW_BAR); bar.x = 0; bar.st = nullptr;
    if (hi - lo > 1) bar = xcd_barrier_post((unsigned*)(F.ctl + CW_BAR), F.MISC + 8);
#ifndef PH_MASK
#define PH_MASK 0xfff
#endif
#define IN(k) (((PH_MASK >> (k)) & 1) && lo <= (k) && (k) < hi)
#define SEAM(k) do { if (IN(k) && IN((k) + 1)) xcd_barrier(bar); } while (0)

    if (IN(0)) { ARGS_NOW(A); p0_prologue(F, A); SEAM(0); }
    if (IN(1)) {
        ARGS_NOW(A); unsigned char* ws = A->ws;
        pg8::Gemm g{(const bf16*)(ws + WS_H0), (const bf16*)(ws + WS_WIN), MP, NPROJ, DM}; pg8::StaticOrder S; S.init(MP, NPROJ, F.G, (int)blockIdx.x);
        EpiProj E{(bf16*)(ws + WS_PROJ), A->out};
        pg8::gemm_phase<EpiProj, pg8::StaticOrder, true, true>(F.lds, g, S, E);
        { RowProj R{(bf16*)(ws + WS_PROJ), A->out};
          for (int rep = 0; rep < REP_SG; ++rep) for (int u = F.vcu; u < 16 * 12; u += F.G) small_gemm_unit<4>(F, (const bf16*)(ws + WS_H0), (const bf16*)(ws + WS_WIN), DM, MP + 64 * (u & 15), 256 * (u >> 4), R); }
        SEAM(1);
    }
    if (IN(2)) {
        ARGS_NOW(A); unsigned char* ws = A->ws; const bf16* PROJ = (const bf16*)(ws + WS_PROJ); bf16* MIX = (bf16*)(ws + WS_MIX);
        for (int rep = 0; rep < REP_AP; ++rep)
        for (int u = F.vcu; u < 256; u += F.G) attn_prompt_unit(F, PROJ, MIX, u >> 5, (u >> 2) & 7, u & 3);
        for (int rep = 0; rep < REP_AS; ++rep)
        for (int u = F.vcu; u < 256; u += F.G) { const int task = 4 * u + (F.wave >> 1); attn_sample_task(F, PROJ, A->in[I_CK], A->in[I_CV], MIX, task >> 3, task & 7, F.wave & 1, F.wave >> 1); }
        for (int rep = 0; rep < REP_SS; ++rep)
        for (int u = F.vcu; u < 256; u += F.G) ssd_states_unit(F, A, u >> 5, (u >> 1) & 15, u & 1);
        for (int rep = 0; rep < REP_SS; ++rep)
        for (int u = F.vcu; u < 256; u += F.G) ssd_sample_unit(F, A, u >> 1, u & 1);
        float* outp = A->out;
        for (int idx = F.vcu * 512 + F.tid; idx < NBATCH * 3 * CONVD; idx += F.G * 512) { const int b = idx / (3 * CONVD), rem = idx % (3 * CONVD), j = rem / CONVD, ch = rem % CONVD;
            outp[O_CP + idx] = bf2f(PROJ[(size_t)(b * SEQ + SEQ - 3 + j) * NPROJ + CXB + ch]); }
        SEAM(2);
    }
    if (IN(3)) { ARGS_NOW(A); for (int u = F.vcu; u < 256; u += F.G) ssd_scan_unit(F, A, u); SEAM(3); }
    if (IN(4)) { ARGS_NOW(A); for (int rep = 0; rep < REP_SO; ++rep) for (int u = F.vcu; u < 256; u += F.G) ssd_out_unit(F, A, u >> 5, (u >> 1) & 15, u & 1); SEAM(4); }
    if (IN(5)) {
        ARGS_NOW(A); unsigned char* ws = A->ws;
        pg8::Gemm g{(const bf16*)(ws + WS_MIX), (const bf16*)(ws + WS_WOUT), MP, DM, DM}; pg8::StaticOrder S; S.init(MP, DM, F.G, (int)blockIdx.x);
        EpiOut E{(const bf16*)(ws + WS_H0), (bf16*)(ws + WS_V1), (float*)(ws + WS_ST1)};
        pg8::gemm_phase<EpiOut, pg8::StaticOrder, true, true>(F.lds, g, S, E);
        { RowOut R{(const bf16*)(ws + WS_H0), (bf16*)(ws + WS_V1), (float*)(ws + WS_ST1)};
          for (int u = F.vcu; u < 256; u += F.G) small_gemm_unit<1>(F, (const bf16*)(ws + WS_MIX), (const bf16*)(ws + WS_WOUT), DM, MP + 64 * (u & 15), 64 * (u >> 4), R); }
        SEAM(5);
    }
    if (IN(6)) {
        ARGS_NOW(A); unsigned char* ws = A->ws;
        pg8::Gemm g{(const bf16*)(ws + WS_V1), (const bf16*)(ws + WS_WUP), MP, DFF, DM}; pg8::StaticOrder S; S.init(MP, DFF, F.G, (int)blockIdx.x);
        EpiUp E{(bf16*)(ws + WS_U), (const float*)(ws + WS_ST1), (const float*)(ws + WS_CSUP), (const float*)(ws + WS_BWUP)};
        pg8::gemm_phase<EpiUp, pg8::StaticOrder, true, true>(F.lds, g, S, E);
        { RowUp R{(bf16*)(ws + WS_U), (const float*)(ws + WS_ST1), (const float*)(ws + WS_CSUP), (const float*)(ws + WS_BWUP)};
          for (int rep = 0; rep < REP_SG; ++rep) for (int u = F.vcu; u < 256; u += F.G) small_gemm_unit<4>(F, (const bf16*)(ws + WS_V1), (const bf16*)(ws + WS_WUP), DM, MP + 64 * (u & 15), 256 * (u >> 4), R); }
        SEAM(6);
    }
    if (IN(7)) {
        if ((PH_MASK >> 11) & 1) { ARGS_NOW(A); unsigned char* ws = A->ws;
          pg8::Gemm g{(const bf16*)(ws + WS_U), (const bf16*)(ws + WS_WDOWN), MP, DM, DFF}; pg8::StaticOrder S; S.init(MP, DM, F.G, (int)blockIdx.x);
          EpiDown E{(const bf16*)(ws + WS_V1), (bf16*)(ws + WS_V2), (const float*)(ws + WS_ST1), (float*)(ws + WS_ST2), A->in[I_LN1G], A->in[I_LN1B]};
          pg8::gemm_phase<EpiDown, pg8::StaticOrder, true, true>(F.lds, g, S, E);
          RowDown R{(const bf16*)(ws + WS_V1), (bf16*)(ws + WS_V2), (const float*)(ws + WS_ST1), (float*)(ws + WS_ST2), A->in[I_LN1G], A->in[I_LN1B]};
          for (int u = F.vcu; u < 256; u += F.G) small_gemm_unit<1>(F, (const bf16*)(ws + WS_U), (const bf16*)(ws + WS_WDOWN), DFF, MP + 64 * (u & 15), 64 * (u >> 4), R); }
        __syncthreads();
        if ((PH_MASK >> 10) & 1) { ARGS_NOW(A); unsigned char* ws = A->ws;
          int kple = DPLE; asm volatile("" : "+s"(kple));
          pg8::Gemm g{(const bf16*)(ws + WS_PE), (const bf16*)(ws + WS_WPLE), MP, DM, kple}; pg8::StaticOrder S; S.init(MP, DM, F.G, (int)blockIdx.x);
          EpiPle E{(bf16*)(ws + WS_PLE)};
          pg8::gemm_phase<EpiPle, pg8::StaticOrder, true, true>(F.lds, g, S, E);
          RowPle R{(bf16*)(ws + WS_PLE)};
          for (int u = F.vcu; u < 256; u += F.G) small_gemm_unit<1>(F, (const bf16*)(ws + WS_PE), (const bf16*)(ws + WS_WPLE), kple, MP + 64 * (u & 15), 64 * (u >> 4), R); }
        SEAM(7);
    }
    if (IN(8)) {
        ARGS_NOW(A); unsigned char* ws = A->ws;
        pg8::Gemm g{(const bf16*)(ws + WS_V2), (const bf16*)(ws + WS_WGATE), MP, DM, DM}; pg8::StaticOrder S; S.init(MP, DM, F.G, (int)blockIdx.x);
        EpiGate E{(const bf16*)(ws + WS_V2), (const bf16*)(ws + WS_PLE), A->out + O_Y, (const float*)(ws + WS_ST2), (const float*)(ws + WS_CSG), (const float*)(ws + WS_BWG), A->in[I_LN2G], A->in[I_LN2B]};
        pg8::gemm_phase<EpiGate, pg8::StaticOrder, true, true>(F.lds, g, S, E);
        { RowGate R{(const bf16*)(ws + WS_V2), (const bf16*)(ws + WS_PLE), A->out + O_Y, (const float*)(ws + WS_ST2), (const float*)(ws + WS_CSG), (const float*)(ws + WS_BWG), A->in[I_LN2G], A->in[I_LN2B]};
          for (int u = F.vcu; u < 256; u += F.G) small_gemm_unit<1>(F, (const bf16*)(ws + WS_V2), (const bf16*)(ws + WS_WGATE), DM, MP + 64 * (u & 15), 64 * (u >> 4), R); }
        SEAM(8);
    }
    if (IN(9)) { ARGS_NOW(A); p9_final_ln(F, A); }
#undef IN
#undef SEAM
}

extern "C" void kernel_launch(void* const* d_in, const int* in_sizes, int n_in, void* d_out, int out_size, void* d_ws, size_t ws_size, hipStream_t stream) {
    static int grid = 0;
    if (grid == 0) {
        if (n_in != 28 || out_size != (int)O_END || ws_size < WS_END) { fprintf(stderr, "kernel_launch: unexpected problem shape (n_in %d, out %d, ws %zu); nothing launched\n", n_in, out_size, ws_size); grid = -1; return; }
        int dev = 0, cus = 0, per_cu = 0;
        if (hipGetDevice(&dev) != hipSuccess || hipDeviceGetAttribute(&cus, hipDeviceAttributeMultiprocessorCount, dev) != hipSuccess) { fprintf(stderr, "kernel_launch: device query failed\n"); grid = -1; return; }
        if (hipFuncSetAttribute((const void*)fwd_kernel, hipFuncAttributeMaxDynamicSharedMemorySize, LDS_BYTES) != hipSuccess) { fprintf(stderr, "kernel_launch: hipFuncSetAttribute failed\n"); grid = -1; return; }
        if (hipOccupancyMaxActiveBlocksPerMultiprocessor(&per_cu, (const void*)fwd_kernel, NWAVES * 64, LDS_BYTES) != hipSuccess || per_cu < 1)
            fprintf(stderr, "kernel_launch: note: occupancy query reports %d workgroups per CU\n", per_cu);
        (void)hipGetLastError();
        grid = cus;
    }
    if (grid < 0) return;
    if (hipMemsetAsync((char*)d_ws + WS_CTL, 0, CTL_ZERO_BYTES, stream) != hipSuccess) { fprintf(stderr, "kernel_launch: memset failed\n"); return; }
    Args a{};
    for (int i = 0; i < 28; ++i) a.in[i] = (const float*)d_in[i];
    a.out = (float*)d_out; a.ws = (unsigned char*)d_ws;
#if MK_ONE_LAUNCH
    a.ph_lo = 0; a.ph_hi = NPH;
    hipLaunchKernelGGL(fwd_kernel, dim3(grid), dim3(NWAVES * 64), LDS_BYTES, stream, a);
#else
    for (int p = 0; p < NPH; ++p) { a.ph_lo = p; a.ph_hi = p + 1; hipLaunchKernelGGL(fwd_kernel, dim3(grid), dim3(NWAVES * 64), LDS_BYTES, stream, a); }
#endif
    const hipError_t le = hipPeekAtLastError();
    if (le != hipSuccess) fprintf(stderr, "kernel_launch: launch failed: %s\n", hipGetErrorName(le));
}
```

```cpp
#include <hip/hip_runtime.h>
#include <cstdio>
#include <cstdint>
namespace pg8 {
#define PG8_LAS __attribute__((address_space(3)))
typedef unsigned short bf16_t;
typedef short bf16x8 __attribute__((ext_vector_type(8)));
typedef float f32x4 __attribute__((ext_vector_type(4)));
typedef unsigned u32x4 __attribute__((ext_vector_type(4)));
constexpr int BM = 256, BK = 64, HALF = 128, HTB = HALF * BK * 2  , STAGE_BYTES = 8 * HTB, NXCD = 8, WGM = 8;

__host__ __device__ __forceinline__ int lds_byte(int r, int c) { const int st = (r >> 4) * 2 + (c >> 5), rr = r & 15, cc = c & 31, ob = rr * 64 + cc * 2; return st * 1024 + (ob ^ (((ob >> 9) & 1) << 5)); }
__host__ __device__ __forceinline__ void stage_rc(int b, int& R, int& C) { const int st = b / 1024, sb = b % 1024, swz = sb ^ (((sb >> 9) & 1) << 5); R = (st >> 1) * 16 + swz / 64; C = (st & 1) * 32 + (swz % 64) / 2; }
__host__ __device__ __forceinline__ int perm32(int rho) { const int n = rho >> 4, i = rho & 15; return 8 * (i >> 2) + 4 * n + (i & 3); }

struct Unit { int pm, pn; };
struct Gemm { const bf16_t* A; const bf16_t* Bt; int M, N, K; };

struct StaticOrder {
    int nM, nN, nwg, G, c;
    __host__ __device__ void init(int M, int N, int G_, int c_) { nM = M / BM; nN = N / BM; nwg = nM * nN; G = G_; c = c_; }
    __host__ __device__ bool next(int i, Unit& u) const {
        const long L = (long)i * G + c; if (L >= nwg) return false;
        int wgid = (int)L; { const int q = nwg / NXCD, r = nwg % NXCD, xcd = wgid % NXCD, off = wgid / NXCD; wgid = (xcd < r ? xcd * (q + 1) : r * (q + 1) + (xcd - r) * q) + off; }
        const int nig = WGM * nN, gid = wgid / nig, fm = gid * WGM, gsz = (nM - fm) < WGM ? (nM - fm) : WGM;
        u.pm = fm + ((wgid % nig) % gsz); u.pn = (wgid % nig) / gsz; return true;
    }
    __device__ __forceinline__ void a_ready(const Unit&) const {}
    __device__ __forceinline__ void done(const Unit&) const {}
};
__device__ __forceinline__ unsigned cvt_pk_bf16(float lo, float hi) { unsigned r; asm volatile("v_cvt_pk_bf16_f32 %0, %1, %2" : "=v"(r) : "v"(lo), "v"(hi)); return r; }
typedef float f32x2 __attribute__((ext_vector_type(2)));
template <class Epi, class Sched, bool ALIGN_EPI = false, bool SP2 = false>
__device__ __forceinline__ void gemm_phase(PG8_LAS unsigned char* lds, const Gemm g, const Sched& S, const Epi& E) {
    const int tid = threadIdx.x, wid = __builtin_amdgcn_readfirstlane(tid >> 6), lane = tid & 63, wr = wid >> 2, wc = wid & 3, fr = lane & 15, fq = lane >> 4;
    const int K = g.K, nt = K / BK;
    unsigned voffA[2], voffB[2];
#pragma unroll
    for (int i = 0; i < 2; ++i) { int R, C; stage_rc(tid * 16 + i * 8192, R, C); const int Rb = Epi::PERM ? ((R & ~31) + perm32(R & 31)) : R;
        voffA[i] = (unsigned)(R * K + C) * 2u; voffB[i] = (unsigned)(Rb * K + C) * 2u; }
    const size_t kstep = (size_t)(BK * 2);
    const size_t hstep = (size_t)HALF * K * 2;
    const size_t tstep = 2 * hstep;
    const unsigned ldsw = (unsigned)wid * 1024u;
    const int aoff = lds_byte(wr * 64 + fr, fq * 8), boff = lds_byte(wc * 32 + fr, fq * 8);
#define PG8_SA(b, h) (((b) * 2 + (h)) * HTB)
#define PG8_SB(b, h) ((4 + (b) * 2 + (h)) * HTB)
#define PG8_STAGE(bufoff, gbase, voff) do { _Pragma("unroll") for (int _i = 0; _i < 2; ++_i) \
        __builtin_amdgcn_global_load_lds((const unsigned*)((const char*)(gbase) + (voff)[_i]), (PG8_LAS unsigned*)(lds + (bufoff) + ldsw + _i * 8192), 16, 0, 0); } while (0)
#define PG8_LDA(dst, b, h) do { _Pragma("unroll") for (int m = 0; m < 4; ++m) _Pragma("unroll") for (int k = 0; k < 2; ++k) dst[m][k] = *(const PG8_LAS bf16x8*)(lds + PG8_SA(b, h) + aoff + m * 2048 + k * 1024); } while (0)
#define PG8_LDB(dst, b, h) do { _Pragma("unroll") for (int n = 0; n < 2; ++n) _Pragma("unroll") for (int k = 0; k < 2; ++k) dst[n][k] = *(const PG8_LAS bf16x8*)(lds + PG8_SB(b, h) + boff + n * 2048 + k * 1024); } while (0)
#define PG8_MMA(ai, bj, At, Bt) do { __builtin_amdgcn_s_setprio(1); _Pragma("unroll") for (int m = 0; m < 4; ++m) _Pragma("unroll") for (int n = 0; n < 2; ++n) _Pragma("unroll") for (int k = 0; k < 2; ++k) \
        acc[ai][bj][m][n] = __builtin_amdgcn_mfma_f32_16x16x32_bf16(Bt[n][k], At[m][k], acc[ai][bj][m][n], 0, 0, 0); __builtin_amdgcn_s_setprio(0); } while (0)
#define PG8_WAIT_V(n) asm volatile("s_waitcnt vmcnt(" #n ")" ::: "memory")
#define PG8_WAIT_L(n) asm volatile("s_waitcnt lgkmcnt(" #n ")" ::: "memory")
#define PG8_BAR __builtin_amdgcn_s_barrier()
#define PG8_SCHED __builtin_amdgcn_sched_barrier(0)
    Unit cur, nxt; int ui = 0;
    if (!S.next(0, cur)) return;
    f32x4 acc[2][2][4][2];
#pragma unroll
    for (int a = 0; a < 2; ++a)
#pragma unroll
        for (int b = 0; b < 2; ++b)
#pragma unroll
            for (int m = 0; m < 4; ++m)
#pragma unroll
                for (int n = 0; n < 2; ++n) acc[a][b][m][n] = (f32x4){0.f, 0.f, 0.f, 0.f};
    bf16x8 At[4][2], B0[2][2], B1[2][2];
    const char* cA = (const char*)g.A + (size_t)cur.pm * tstep; const char* cB = (const char*)g.Bt + (size_t)cur.pn * tstep;
    S.a_ready(cur);
    if constexpr (SP2) {
        PG8_STAGE(PG8_SB(0, 0), cB, voffB); PG8_STAGE(PG8_SB(0, 1), cB + hstep, voffB); PG8_STAGE(PG8_SA(0, 0), cA, voffA); PG8_STAGE(PG8_SA(0, 1), cA + hstep, voffA);
        if (wr == 1) PG8_BAR;
        PG8_WAIT_V(2); PG8_BAR;
        PG8_STAGE(PG8_SB(1, 0), cB + kstep, voffB); PG8_STAGE(PG8_SA(1, 0), cA + kstep, voffA); PG8_STAGE(PG8_SB(1, 1), cB + hstep + kstep, voffB);
        PG8_WAIT_V(6); PG8_BAR;
    } else {
        PG8_STAGE(PG8_SB(0, 0), cB, voffB); PG8_STAGE(PG8_SA(0, 0), cA, voffA); PG8_STAGE(PG8_SB(0, 1), cB + hstep, voffB); PG8_STAGE(PG8_SA(0, 1), cA + hstep, voffA);
        if (wr == 1) PG8_BAR;
        PG8_WAIT_V(4); PG8_BAR;
        PG8_STAGE(PG8_SB(1, 0), cB + kstep, voffB); PG8_STAGE(PG8_SA(1, 0), cA + kstep, voffA); PG8_STAGE(PG8_SB(1, 1), cB + hstep + kstep, voffB);
        PG8_WAIT_V(6); PG8_BAR;
    }
    for (;;) {
        const bool has_next = S.next(ui + 1, nxt);
        const char* nA = has_next ? (const char*)g.A + (size_t)nxt.pm * tstep : cA; const char* nB = has_next ? (const char*)g.Bt + (size_t)nxt.pn * tstep : cB;
        for (int t = 0; t < nt; t += 2) {
            const bool last = (t == nt - 2);
            const char* a1 = cA + (size_t)(t + 1) * kstep;
            const char* a2 = last ? nA : cA + (size_t)(t + 2) * kstep; const char* b2 = last ? nB : cB + (size_t)(t + 2) * kstep;
            const char* a3 = a2 + kstep; const char* b3 = b2 + kstep;
            if (last && has_next) S.a_ready(nxt);
            if constexpr (SP2) {
            PG8_LDB(B0, 0, 0); PG8_LDB(B1, 0, 1); PG8_SCHED; PG8_LDA(At, 0, 0); PG8_STAGE(PG8_SA(1, 1), a1 + hstep, voffA);
            PG8_WAIT_V(8); PG8_WAIT_L(0); PG8_BAR; PG8_MMA(0, 0, At, B0); PG8_MMA(0, 1, At, B1); PG8_BAR; PG8_SCHED;
            PG8_LDA(At, 0, 1); PG8_STAGE(PG8_SB(0, 0), b2, voffB); PG8_STAGE(PG8_SB(0, 1), b2 + hstep, voffB); PG8_STAGE(PG8_SA(0, 0), a2, voffA);
            PG8_WAIT_V(8); PG8_WAIT_L(0); PG8_BAR; PG8_MMA(1, 0, At, B0); PG8_MMA(1, 1, At, B1); PG8_BAR; PG8_SCHED;
            PG8_LDB(B0, 1, 0); PG8_LDB(B1, 1, 1); PG8_SCHED; PG8_LDA(At, 1, 0); PG8_STAGE(PG8_SA(0, 1), a2 + hstep, voffA);
            PG8_WAIT_V(8); PG8_WAIT_L(0); PG8_BAR; PG8_MMA(0, 0, At, B0); PG8_MMA(0, 1, At, B1); PG8_BAR; PG8_SCHED;
            PG8_LDA(At, 1, 1); PG8_STAGE(PG8_SB(1, 0), b3, voffB); PG8_STAGE(PG8_SB(1, 1), b3 + hstep, voffB); PG8_STAGE(PG8_SA(1, 0), a3, voffA);
            PG8_WAIT_V(8); PG8_WAIT_L(0); PG8_BAR; PG8_MMA(1, 0, At, B0); PG8_MMA(1, 1, At, B1); PG8_BAR; PG8_SCHED;
            } else {
            PG8_LDB(B0, 0, 0); PG8_SCHED; PG8_LDA(At, 0, 0); PG8_STAGE(PG8_SA(1, 1), a1 + hstep, voffA);
            PG8_WAIT_L(8); PG8_BAR; PG8_WAIT_L(0); PG8_MMA(0, 0, At, B0); PG8_BAR; PG8_SCHED;
            PG8_LDB(B1, 0, 1); PG8_STAGE(PG8_SB(0, 0), b2, voffB);
            PG8_BAR; PG8_WAIT_L(0); PG8_MMA(0, 1, At, B1); PG8_BAR;
            PG8_LDA(At, 0, 1); PG8_STAGE(PG8_SA(0, 0), a2, voffA);
            PG8_BAR; PG8_WAIT_L(0); PG8_MMA(1, 0, At, B0); PG8_BAR; PG8_SCHED;
            PG8_STAGE(PG8_SB(0, 1), b2 + hstep, voffB);
            PG8_WAIT_V(6); PG8_BAR; PG8_MMA(1, 1, At, B1); PG8_BAR;
            PG8_LDB(B0, 1, 0); PG8_SCHED; PG8_LDA(At, 1, 0); PG8_STAGE(PG8_SA(0, 1), a2 + hstep, voffA);
            PG8_WAIT_L(8); PG8_BAR; PG8_WAIT_L(0); PG8_MMA(0, 0, At, B0); PG8_BAR; PG8_SCHED;
            PG8_LDB(B1, 1, 1); PG8_STAGE(PG8_SB(1, 0), b3, voffB);
            PG8_BAR; PG8_WAIT_L(0); PG8_MMA(0, 1, At, B1); PG8_BAR;
            PG8_LDA(At, 1, 1); PG8_STAGE(PG8_SA(1, 0), a3, voffA);
            PG8_BAR; PG8_WAIT_L(0); PG8_MMA(1, 0, At, B0); PG8_BAR; PG8_SCHED;
            PG8_STAGE(PG8_SB(1, 1), b3 + hstep, voffB);
            PG8_WAIT_V(6); PG8_BAR; PG8_MMA(1, 1, At, B1); PG8_BAR;
            }
        }
        if constexpr (ALIGN_EPI) { if (wr == 0) PG8_BAR; }
        if constexpr (!Epi::AFTER_DRAIN) { E(acc, cur, wr, wc, fr, fq); S.done(cur); }
        if (!has_next) break;
#pragma unroll
        for (int a = 0; a < 2; ++a)
#pragma unroll
            for (int b = 0; b < 2; ++b)
#pragma unroll
                for (int m = 0; m < 4; ++m)
#pragma unroll
                    for (int n = 0; n < 2; ++n) acc[a][b][m][n] = (f32x4){0.f, 0.f, 0.f, 0.f};
        cur = nxt; cA = nA; cB = nB; ++ui;
        if constexpr (ALIGN_EPI) { if (wr == 1) PG8_BAR; }
    }
    PG8_WAIT_V(0);
    if constexpr (!ALIGN_EPI) { if (wr == 0) PG8_BAR; }
    PG8_BAR;
    if constexpr (Epi::AFTER_DRAIN) { E.fused(acc, cur, wr, wc, fr, fq, lds, wid, lane); S.done(cur); }
#undef PG8_SA
#undef PG8_SB
#undef PG8_STAGE
#undef PG8_LDA
#undef PG8_LDB
#undef PG8_MMA
#undef PG8_WAIT_V
#undef PG8_WAIT_L
#undef PG8_BAR
#undef PG8_SCHED
}
}
constexpr int DM = 1024, NBATCH = 8, SEQ = 2048, MP = NBATCH * SEQ, DECB = 128, DECT = 8, MS = DECB * DECT, M = MP + MS;
constexpr int NPROJ = 3072, NINP = 3080, HD = 64, NH = 8, DST = 128, DFF = 4096, DPLE = 256, CONVD = 1024, WBUF = 2048;
constexpr int CQ = 0, CK = 512, CV = 1024, CZ = 1536, CXB = 2048;
constexpr float LN_EPS = 1e-5f, ALPHA = 1.189207115002721f, LOG2E = 1.4426950408889634f;
constexpr size_t O_Y = 0, O_KP = 17825792, O_VP = 26214400, O_KS = 34603008, O_VS = 35127296, O_CP = 35651584, O_CS = 35676160, O_SP = 36069376, O_SS = 36593664, O_END = 44982272;
constexpr size_t MiB = 1u << 20;
constexpr size_t WS_CTL = 0, CTL_ZERO_BYTES = 1 * MiB;
constexpr size_t WS_ST1 = 65536, WS_ST2 = 262144, WS_CSUP = 524288, WS_BWUP = 540672, WS_CSG = 557056, WS_BWG = 561152;
constexpr size_t WS_WIN = 2 * MiB, WS_WOUT = 8 * MiB, WS_WUP = 10 * MiB, WS_WDOWN = 18 * MiB, WS_WGATE = 26 * MiB, WS_WPLE = 28 * MiB;
constexpr size_t WS_DT = 29 * MiB, WS_ATOT = 30 * MiB, WS_H0 = 32 * MiB, WS_PE = 66 * MiB, WS_PROJ = 76 * MiB, WS_MIX = 178 * MiB, WS_V1 = 212 * MiB, WS_V2 = 246 * MiB;
constexpr size_t WS_PLE = 280 * MiB, WS_STLOC = 314 * MiB, WS_U = 346 * MiB, WS_WUP2 = 482 * MiB, WS_END = 492 * MiB;
constexpr int CW_TMO = 0, CW_BAR = 4096;
constexpr int RING_BYTES = 151552;
constexpr int LDSCTL_OFF = RING_BYTES, MISC_OFF = LDSCTL_OFF + 320;
constexpr int LDS_BYTES = 155648;
constexpr int NWAVES = 8;

#define GAS __attribute__((address_space(1)))
#define LAS __attribute__((address_space(3)))
typedef unsigned short bf16;
typedef unsigned v4u __attribute__((ext_vector_type(4)));
typedef unsigned v2u __attribute__((ext_vector_type(2)));
typedef float f32x4 __attribute__((ext_vector_type(4)));
typedef float f32x16 __attribute__((ext_vector_type(16)));
typedef short bf16x8 __attribute__((ext_vector_type(8)));
typedef short s16x4 __attribute__((ext_vector_type(4)));
typedef GAS unsigned gu32;
#define RLX_AGENT __ATOMIC_RELAXED, __HIP_MEMORY_SCOPE_AGENT
#define LDS_WAIT() asm volatile("s_waitcnt lgkmcnt(0)" ::: "memory")
#define VM_WAIT() asm volatile("s_waitcnt vmcnt(0)" ::: "memory")
__device__ __forceinline__ unsigned f2bf(float f) { unsigned u = __builtin_bit_cast(unsigned, f); return (u + 0x7fffu + ((u >> 16) & 1u)) >> 16; }
typedef float f32x2_t __attribute__((ext_vector_type(2))); typedef __bf16 bf16x2_t __attribute__((ext_vector_type(2)));
__device__ __forceinline__ unsigned pk2(float lo, float hi) { f32x2_t v = {lo, hi}; bf16x2_t b = __builtin_convertvector(v, bf16x2_t); return __builtin_bit_cast(unsigned, b); }
__device__ __forceinline__ float bf2f(unsigned short h) { return __builtin_bit_cast(float, (unsigned)h << 16); }
__device__ __forceinline__ float bflo(unsigned w) { return __builtin_bit_cast(float, w << 16); }
__device__ __forceinline__ float bfhi(unsigned w) { return __builtin_bit_cast(float, w & 0xffff0000u); }
__device__ __forceinline__ float fast_exp2(float x) { return __builtin_amdgcn_exp2f(x); }
__device__ __forceinline__ float fast_exp(float x) { return __builtin_amdgcn_exp2f(x * LOG2E); }
__device__ __forceinline__ float sigmoidf_(float x) { return 1.0f / (1.0f + fast_exp(-x)); }
__device__ __forceinline__ float siluf_(float x) { return x * sigmoidf_(x); }
__device__ __forceinline__ int crow(int r, int hi) { return (r & 3) + 8 * (r >> 2) + 4 * hi; }
__device__ __forceinline__ float wave_sum(float v) {
#pragma unroll
    for (int o = 1; o < 64; o <<= 1) v += __shfl_xor(v, o);
    return v;
}
__device__ __forceinline__ bf16x8 pack8(float a0, float a1, float a2, float a3, float a4, float a5, float a6, float a7) {
    v4u w; w.x = pk2(a0, a1); w.y = pk2(a2, a3); w.z = pk2(a4, a5); w.w = pk2(a6, a7); return __builtin_bit_cast(bf16x8, w);
}
__device__ __forceinline__ bf16x8 cvt8(f32x4 a, f32x4 b) { return pack8(a[0], a[1], a[2], a[3], b[0], b[1], b[2], b[3]); }
#define EPI_ARGS const pg8::f32x4 (&acc)[2][2][4][2], const pg8::Unit& u, int wr, int wc, int fr, int fq
__device__ __forceinline__ v4u pack_acc8(const f32x4 a, const f32x4 b) { v4u w; w.x = pk2(a[0], a[1]); w.y = pk2(a[2], a[3]); w.z = pk2(b[0], b[1]); w.w = pk2(b[2], b[3]); return w; }
__device__ __forceinline__ void row_stats(float mu_s, float s2, float& mu, float& rs) { mu = mu_s * (1.0f / DM); const float var = s2 * (1.0f / DM) - mu * mu; rs = 1.0f / sqrtf(fmaxf(var, 0.f) + LN_EPS); }

struct EpiProj {
    static constexpr bool PERM = true, AFTER_DRAIN = false;
    bf16* P; float* out;
    __device__ __forceinline__ void operator()(EPI_ARGS) const {
        const int pn = u.pn; const bool kv = (pn >= 2 && pn < 6); const bool isv = pn >= 4; const bool prompt = u.pm < (MP / 256);
        const int col0 = pn * 256 + wc * 32 + 8 * fq; const int row0 = u.pm * 256 + wr * 64 + fr;
        float* ob = out + (prompt ? (isv ? O_VP : O_KP) : (isv ? O_VS : O_KS)); const int rsub = prompt ? 0 : MP; const int csub = isv ? CV : CK;
#pragma unroll
        for (int ai = 0; ai < 2; ++ai)
#pragma unroll
            for (int m = 0; m < 4; ++m) { const int row = row0 + ai * 128 + m * 16;
#pragma unroll
                for (int bj = 0; bj < 2; ++bj) { const int col = col0 + bj * 128;
                    *(v4u*)(P + (size_t)row * NPROJ + col) = pack_acc8(acc[ai][bj][m][0], acc[ai][bj][m][1]);
                    if (kv) { float* o = ob + (size_t)(row - rsub) * 512 + (col - csub); *(f32x4*)o = acc[ai][bj][m][0]; *(f32x4*)(o + 4) = acc[ai][bj][m][1]; } } }
    }
};
struct EpiOut {
    static constexpr bool PERM = true, AFTER_DRAIN = false;
    const bf16* H0; bf16* V1; float* ST;
    __device__ __forceinline__ void operator()(EPI_ARGS) const {
        const int col0 = u.pn * 256 + wc * 32 + 8 * fq; const int row0 = u.pm * 256 + wr * 64 + fr;
#pragma unroll
        for (int ai = 0; ai < 2; ++ai)
#pragma unroll
            for (int m = 0; m < 4; ++m) { const int row = row0 + ai * 128 + m * 16; float s = 0.f, s2 = 0.f;
#pragma unroll
                for (int bj = 0; bj < 2; ++bj) { const int col = col0 + bj * 128; const size_t off = (size_t)row * DM + col;
                    const v4u hw = *(const v4u*)(H0 + off); f32x4 a = acc[ai][bj][m][0], b = acc[ai][bj][m][1];
                    a[0] += ALPHA * bflo(hw.x); a[1] += ALPHA * bfhi(hw.x); a[2] += ALPHA * bflo(hw.y); a[3] += ALPHA * bfhi(hw.y);
                    b[0] += ALPHA * bflo(hw.z); b[1] += ALPHA * bfhi(hw.z); b[2] += ALPHA * bflo(hw.w); b[3] += ALPHA * bfhi(hw.w);
                    s += (a[0] + a[1]) + (a[2] + a[3]) + (b[0] + b[1]) + (b[2] + b[3]);
                    s2 += (a[0] * a[0] + a[1] * a[1]) + (a[2] * a[2] + a[3] * a[3]) + (b[0] * b[0] + b[1] * b[1]) + (b[2] * b[2] + b[3] * b[3]);
                    *(v4u*)(V1 + off) = pack_acc8(a, b); }
                s += __shfl_xor(s, 16); s += __shfl_xor(s, 32); s2 += __shfl_xor(s2, 16); s2 += __shfl_xor(s2, 32);
                if (fq == 0) { unsafeAtomicAdd(ST + 2 * row, s); unsafeAtomicAdd(ST + 2 * row + 1, s2); } }
    }
};
struct EpiUp {
    static constexpr bool PERM = true, AFTER_DRAIN = false;
    bf16* U; const float* ST; const float* cs; const float* bw;
    __device__ __forceinline__ void operator()(EPI_ARGS) const {
        const int col0 = u.pn * 256 + wc * 32 + 8 * fq; const int row0 = u.pm * 256 + wr * 64 + fr;
#pragma unroll
        for (int bj = 0; bj < 2; ++bj) { const int col = col0 + bj * 128;
            const f32x4 c0 = *(const f32x4*)(cs + col), c1 = *(const f32x4*)(cs + col + 4), w0 = *(const f32x4*)(bw + col), w1 = *(const f32x4*)(bw + col + 4);
#pragma unroll
            for (int ai = 0; ai < 2; ++ai)
#pragma unroll
                for (int m = 0; m < 4; ++m) { const int row = row0 + ai * 128 + m * 16; float mu, rs; row_stats(ST[2 * row], ST[2 * row + 1], mu, rs);
                    f32x4 a = (acc[ai][bj][m][0] - mu * c0) * rs + w0, b = (acc[ai][bj][m][1] - mu * c1) * rs + w1;
#pragma unroll
                    for (int k = 0; k < 4; ++k) { a[k] = fmaxf(a[k], 0.f); a[k] *= a[k]; b[k] = fmaxf(b[k], 0.f); b[k] *= b[k]; }
                    *(v4u*)(U + (size_t)row * DFF + col) = pack_acc8(a, b); } }
    }
};
struct EpiDown {
    static constexpr bool PERM = true, AFTER_DRAIN = false;
    const bf16* V1; bf16* V2; const float* ST1; float* ST2; const float* g; const float* bb;
    __device__ __forceinline__ void operator()(EPI_ARGS) const {
        const int col0 = u.pn * 256 + wc * 32 + 8 * fq; const int row0 = u.pm * 256 + wr * 64 + fr;
        float ss[2][4], ss2[2][4];
#pragma unroll
        for (int ai = 0; ai < 2; ++ai)
#pragma unroll
            for (int m = 0; m < 4; ++m) { ss[ai][m] = 0.f; ss2[ai][m] = 0.f; }
#pragma unroll
        for (int bj = 0; bj < 2; ++bj) { const int col = col0 + bj * 128;
            const f32x4 g0 = *(const f32x4*)(g + col), g1 = *(const f32x4*)(g + col + 4), b0 = *(const f32x4*)(bb + col), b1 = *(const f32x4*)(bb + col + 4);
#pragma unroll
            for (int ai = 0; ai < 2; ++ai)
#pragma unroll
                for (int m = 0; m < 4; ++m) { const int row = row0 + ai * 128 + m * 16; float mu, rs; row_stats(ST1[2 * row], ST1[2 * row + 1], mu, rs);
                    const size_t off = (size_t)row * DM + col; const v4u hw = *(const v4u*)(V1 + off);
                    f32x4 x0 = {bflo(hw.x), bfhi(hw.x), bflo(hw.y), bfhi(hw.y)}, x1 = {bflo(hw.z), bfhi(hw.z), bflo(hw.w), bfhi(hw.w)};
                    const f32x4 a = acc[ai][bj][m][0] + ALPHA * ((x0 - mu) * rs * g0 + b0), b = acc[ai][bj][m][1] + ALPHA * ((x1 - mu) * rs * g1 + b1);
                    ss[ai][m] += (a[0] + a[1]) + (a[2] + a[3]) + (b[0] + b[1]) + (b[2] + b[3]);
                    ss2[ai][m] += (a[0] * a[0] + a[1] * a[1]) + (a[2] * a[2] + a[3] * a[3]) + (b[0] * b[0] + b[1] * b[1]) + (b[2] * b[2] + b[3] * b[3]);
                    *(v4u*)(V2 + off) = pack_acc8(a, b); } }
#pragma unroll
        for (int ai = 0; ai < 2; ++ai)
#pragma unroll
            for (int m = 0; m < 4; ++m) { const int row = row0 + ai * 128 + m * 16; float s = ss[ai][m], s2 = ss2[ai][m];
                s += __shfl_xor(s, 16); s += __shfl_xor(s, 32); s2 += __shfl_xor(s2, 16); s2 += __shfl_xor(s2, 32);
                if (fq == 0) { unsafeAtomicAdd(ST2 + 2 * row, s); unsafeAtomicAdd(ST2 + 2 * row + 1, s2); } }
    }
};
struct EpiPle {
    static constexpr bool PERM = true, AFTER_DRAIN = false;
    bf16* O;
    __device__ __forceinline__ void operator()(EPI_ARGS) const {
        const int col0 = u.pn * 256 + wc * 32 + 8 * fq; const int row0 = u.pm * 256 + wr * 64 + fr;
#pragma unroll
        for (int ai = 0; ai < 2; ++ai)
#pragma unroll
            for (int m = 0; m < 4; ++m)
#pragma unroll
                for (int bj = 0; bj < 2; ++bj) *(v4u*)(O + (size_t)(row0 + ai * 128 + m * 16) * DM + col0 + bj * 128) = pack_acc8(acc[ai][bj][m][0], acc[ai][bj][m][1]);
    }
};
struct EpiGate {
    static constexpr bool PERM = true, AFTER_DRAIN = false;
    const bf16* V2; const bf16* PLE; float* Y; const float* ST2; const float* cs; const float* bw; const float* g; const float* bb;
    __device__ __forceinline__ void operator()(EPI_ARGS) const {
        const int col0 = u.pn * 256 + wc * 32 + 8 * fq; const int row0 = u.pm * 256 + wr * 64 + fr;
#pragma unroll
        for (int bj = 0; bj < 2; ++bj) { const int col = col0 + bj * 128;
            const f32x4 c0 = *(const f32x4*)(cs + col), c1 = *(const f32x4*)(cs + col + 4), w0 = *(const f32x4*)(bw + col), w1 = *(const f32x4*)(bw + col + 4);
            const f32x4 g0 = *(const f32x4*)(g + col), g1 = *(const f32x4*)(g + col + 4), b0 = *(const f32x4*)(bb + col), b1 = *(const f32x4*)(bb + col + 4);
#pragma unroll
            for (int ai = 0; ai < 2; ++ai)
#pragma unroll
                for (int m = 0; m < 4; ++m) { const int row = row0 + ai * 128 + m * 16; float mu, rs; row_stats(ST2[2 * row], ST2[2 * row + 1], mu, rs);
                    const size_t off = (size_t)row * DM + col; const v4u hw = *(const v4u*)(V2 + off), pw = *(const v4u*)(PLE + off);
                    f32x4 x0 = {bflo(hw.x), bfhi(hw.x), bflo(hw.y), bfhi(hw.y)}, x1 = {bflo(hw.z), bfhi(hw.z), bflo(hw.w), bfhi(hw.w)};
                    f32x4 p0 = {bflo(pw.x), bfhi(pw.x), bflo(pw.y), bfhi(pw.y)}, p1 = {bflo(pw.z), bfhi(pw.z), bflo(pw.w), bfhi(pw.w)};
                    f32x4 ga = (acc[ai][bj][m][0] - mu * c0) * rs + w0, gb = (acc[ai][bj][m][1] - mu * c1) * rs + w1;
#pragma unroll
                    for (int k = 0; k < 4; ++k) { ga[k] = sigmoidf_(ga[k]); gb[k] = sigmoidf_(gb[k]); }
                    const f32x4 a = ALPHA * ((x0 - mu) * rs * g0 + b0) + ga * p0, b = ALPHA * ((x1 - mu) * rs * g1 + b1) + gb * p1;
                    *(f32x4*)(Y + off) = a; *(f32x4*)(Y + off + 4) = b; } }
    }
};
#define XB_TMO      128
#define XB_XCNT(j)  (256  + 64 * (j))
#define XB_XSUB(j)  (1280 + 64 * (j))
#define XB_XGEN(j)  (2304 + 64 * (j))
#define XB_TOP      3328
#define XB_TOPGEN   3392
#define XCD_BAR_WORDS 3456
#define XB_SPIN_CAP (1u << 18)

__device__ __forceinline__ unsigned xb_ld(unsigned* p)              { return __hip_atomic_load(p, __ATOMIC_RELAXED, __HIP_MEMORY_SCOPE_AGENT); }
__device__ __forceinline__ unsigned xb_add(unsigned* p, unsigned v) { return __hip_atomic_fetch_add(p, v, __ATOMIC_RELAXED, __HIP_MEMORY_SCOPE_AGENT); }
__device__ __forceinline__ unsigned xb_xcc_id() { return (unsigned)__builtin_amdgcn_s_getreg((3 << 11) | 20) & 0xFu; }
#define XB_SPIN(cond, bar) do { unsigned _sp = 0; while (cond) { __builtin_amdgcn_s_sleep(1); \
    if ((++_sp & 255u) == 0u) { if (xb_ld(&(bar)[XB_TMO])) break; if (_sp > XB_SPIN_CAP) { atomicAdd(&(bar)[XB_TMO], 1u); break; } } } } while (0)

struct XcdBarrier {
    unsigned* bar; unsigned x; bool t0;
    volatile LAS unsigned* st;
};

__device__ __forceinline__ XcdBarrier xcd_barrier_post(unsigned* bar, volatile LAS unsigned* st, bool t0) {
    XcdBarrier b; b.bar = bar; b.x = xb_xcc_id(); b.st = st; b.t0 = t0;
    if (t0) (void)xb_add(&bar[XB_XCNT(b.x)], 1u);
    return b;
}
__device__ __forceinline__ void xcd_barrier_complete(unsigned* bar, unsigned x, unsigned& nloc, unsigned& nx) {
    const unsigned G = gridDim.x * gridDim.y * gridDim.z;
    unsigned sum, cnt, mine, sp = 0u;
    for (;;) {
        sum = 0u; cnt = 0u; mine = 0u;
#pragma unroll
        for (unsigned j = 0; j < 16; ++j) { const unsigned c = xb_ld(&bar[XB_XCNT(j)]); sum += c; cnt += (c > 0u) ? 1u : 0u; mine = (j == x) ? c : mine; }
        if (sum == G) break;
        __builtin_amdgcn_s_sleep(1);
        if ((++sp & 255u) == 0u) { if (xb_ld(&bar[XB_TMO])) break; if (sp > XB_SPIN_CAP) { atomicAdd(&bar[XB_TMO], 1u); break; } }
    }
    nloc = mine > 0u ? mine : 1u; nx = cnt > 0u ? cnt : 1u;
}

__device__ __forceinline__ void xcd_barrier(const XcdBarrier& b) {
    asm volatile("s_waitcnt vmcnt(0)" ::: "memory");
    __syncthreads();
    if (b.t0) {
        unsigned* bar = b.bar;
        __builtin_amdgcn_s_waitcnt(0);
        unsigned nloc = b.st[0], nx = b.st[1];
        if (nloc == 0u) { xcd_barrier_complete(bar, b.x, nloc, nx); b.st[0] = nloc; b.st[1] = nx; }
        const unsigned old = xb_add(&bar[XB_XSUB(b.x)], 1u);
        const unsigned gen = old / nloc;
        if (old + 1u == (gen + 1u) * nloc) {
            __builtin_amdgcn_fence(__ATOMIC_RELEASE, "agent");
            asm volatile("s_waitcnt vmcnt(0)" ::: "memory");
            const unsigned og = xb_add(&bar[XB_TOP], 1u);
            const unsigned tg = og / nx;
            if (og + 1u == (tg + 1u) * nx) xb_add(&bar[XB_TOPGEN], 1u);
            else XB_SPIN(xb_ld(&bar[XB_TOPGEN]) == tg, bar);
            __builtin_amdgcn_fence(__ATOMIC_ACQUIRE, "agent");
            xb_add(&bar[XB_XGEN(b.x)], 1u);
            asm volatile("s_waitcnt vmcnt(0)" ::: "memory");
        } else {
            XB_SPIN(xb_ld(&bar[XB_XGEN(b.x)]) == gen, bar);
            __builtin_amdgcn_fence(__ATOMIC_ACQUIRE, "agent");
            asm volatile("s_waitcnt vmcnt(0)" ::: "memory");
        }
    }
    __syncthreads();
}
struct Args { const float* in[28]; float* out; unsigned char* ws; int ph_lo, ph_hi; };
typedef const __attribute__((address_space(4))) Args* CArgs;
struct Frame { LAS unsigned char* lds; volatile LAS unsigned* MISC; gu32* ctl; int tid, lane, wave, vcu, G; };
enum { I_XP = 0, I_XS, I_CK, I_CV, I_SCONV, I_SSSM, I_PP, I_PS, I_LNG, I_LNB, I_WIN, I_CONVW, I_CONVB, I_DTB, I_ALOG, I_DSKIP, I_NORMW, I_WOUT, I_LN1G, I_LN1B, I_WUP, I_WDOWN, I_LN2G, I_LN2B, I_WGATE, I_WPLE, I_LN3G, I_LN3B };

template <bool FOLD>
__device__ __forceinline__ void p0_transpose_item(const float* W, int K, int N, int ldw, bf16* WT, LAS float* scr, int item, int lane, const float* g, const float* bvec, float* cs, float* bw, bf16* WT2 = nullptr, int ld2 = 0) {
    const int nblk = N / 32, kb = item / nblk, nb = item % nblk, k0 = 64 * kb, n0 = 32 * nb;
    float csp = 0.f, bwp = 0.f;
#pragma unroll 8
    for (int i = 0; i < 32; ++i) { const int kk = 2 * i + (lane >> 5); float w = W[(size_t)(k0 + kk) * ldw + n0 + (lane & 31)];
        if (FOLD) { const float gk = g[k0 + kk], bk = bvec[k0 + kk]; bwp += w * bk; w *= gk; csp += w; }
        scr[kk * 33 + (lane & 31)] = w; }
    if (FOLD) { csp += __shfl_xor(csp, 32); bwp += __shfl_xor(bwp, 32); if (lane < 32) { unsafeAtomicAdd(cs + n0 + lane, csp); unsafeAtomicAdd(bw + n0 + lane, bwp); } }
    LDS_WAIT(); asm volatile("" ::: "memory");
    const int c = lane & 7;
#pragma unroll
    for (int j = 0; j < 4; ++j) { const int n = (lane >> 3) + 8 * j; const LAS float* s = scr + (8 * c) * 33 + n;
        v4u o; o.x = pk2(s[0 * 33], s[1 * 33]); o.y = pk2(s[2 * 33], s[3 * 33]); o.z = pk2(s[4 * 33], s[5 * 33]); o.w = pk2(s[6 * 33], s[7 * 33]);
        *(v4u*)(WT + (size_t)(n0 + n) * K + k0 + 8 * c) = o; if (WT2) *(v4u*)(WT2 + (size_t)(n0 + n) * ld2 + k0 + 8 * c) = o; }
    LDS_WAIT(); asm volatile("" ::: "memory");
}
__device__ __forceinline__ void p0_prologue(const Frame& F, CArgs A) {
    unsigned char* ws = A->ws;
    LAS float* scr = (LAS float*)(F.lds + F.wave * 8448);
    const int gw = F.vcu * NWAVES + F.wave, NGW = F.G * NWAVES;
    constexpr int I_IN = (DM / 64) * (NPROJ / 32), I_O = (DM / 64) * (DM / 32), I_UP = (DM / 64) * (DFF / 32), I_DN = (DFF / 64) * (DM / 32), I_G = I_O, I_PL = (DPLE / 64) * (DM / 32);
    constexpr int NITEMS = I_IN + I_O + I_UP + I_DN + I_G + I_PL;
    for (int it = gw; it < NITEMS; it += NGW) {
        int r = it;
        if (r < I_IN) { p0_transpose_item<false>(A->in[I_WIN], DM, NPROJ, NINP, (bf16*)(ws + WS_WIN), scr, r, F.lane, nullptr, nullptr, nullptr, nullptr); continue; } r -= I_IN;
        if (r < I_O) { p0_transpose_item<false>(A->in[I_WOUT], DM, DM, DM, (bf16*)(ws + WS_WOUT), scr, r, F.lane, nullptr, nullptr, nullptr, nullptr); continue; } r -= I_O;
        if (r < I_UP) { p0_transpose_item<true>(A->in[I_WUP], DM, DFF, DFF, (bf16*)(ws + WS_WUP), scr, r, F.lane, A->in[I_LN1G], A->in[I_LN1B], (float*)(ws + WS_CSUP), (float*)(ws + WS_BWUP)); continue; } r -= I_UP;
        if (r < I_DN) { p0_transpose_item<false>(A->in[I_WDOWN], DFF, DM, DM, (bf16*)(ws + WS_WDOWN), scr, r, F.lane, nullptr, nullptr, nullptr, nullptr); continue; } r -= I_DN;
        if (r < I_G) { p0_transpose_item<true>(A->in[I_WGATE], DM, DM, DM, (bf16*)(ws + WS_WGATE), scr, r, F.lane, A->in[I_LN2G], A->in[I_LN2B], (float*)(ws + WS_CSG), (float*)(ws + WS_BWG)); continue; } r -= I_G;
        p0_transpose_item<false>(A->in[I_WPLE], DPLE, DM, DM, (bf16*)(ws + WS_WPLE), scr, r, F.lane, nullptr, nullptr, nullptr, nullptr);
    }
    LAS float* wdt = (LAS float*)(F.lds + 69632);
    for (int idx = F.tid; idx < 8192; idx += NWAVES * 64) wdt[idx] = A->in[I_WIN][(size_t)(idx >> 3) * NINP + NPROJ + (idx & 7)];
    __syncthreads();
    f32x4 gv[4], bv[4];
#pragma unroll
    for (int j = 0; j < 4; ++j) { gv[j] = ((const f32x4*)A->in[I_LNG])[F.lane + 64 * j]; bv[j] = ((const f32x4*)A->in[I_LNB])[F.lane + 64 * j]; }
    bf16* H0 = (bf16*)(ws + WS_H0); bf16* PE = (bf16*)(ws + WS_PE); float* DT = (float*)(ws + WS_DT);
    for (int m = gw; m < M; m += NGW) {
        const float* xrow = m < MP ? A->in[I_XP] + (size_t)m * DM : A->in[I_XS] + (size_t)(m - MP) * DM;
        f32x4 v[4]; float s = 0.f;
#pragma unroll
        for (int j = 0; j < 4; ++j) { v[j] = ((const f32x4*)xrow)[F.lane + 64 * j]; s += (v[j][0] + v[j][1]) + (v[j][2] + v[j][3]); }
        const float mean = wave_sum(s) * (1.f / DM); float s2 = 0.f;
#pragma unroll
        for (int j = 0; j < 4; ++j) { v[j] = v[j] - mean; s2 += (v[j][0] * v[j][0] + v[j][1] * v[j][1]) + (v[j][2] * v[j][2] + v[j][3] * v[j][3]); }
        const float rstd = 1.f / sqrtf(wave_sum(s2) * (1.f / DM) + LN_EPS);
        float d[8];
#pragma unroll
        for (int q = 0; q < 8; ++q) d[q] = 0.f;
        unsigned long long* o8 = (unsigned long long*)(H0 + (size_t)m * DM) + F.lane;
#pragma unroll
        for (int j = 0; j < 4; ++j) { v[j] = v[j] * rstd * gv[j] + bv[j];
            o8[64 * j] = (unsigned long long)pk2(v[j][0], v[j][1]) | ((unsigned long long)pk2(v[j][2], v[j][3]) << 32);
#pragma unroll
            for (int e = 0; e < 4; ++e) { const LAS float* wr_ = wdt + (4 * F.lane + 256 * j + e) * 8; const f32x4 w0 = *(const LAS f32x4*)wr_, w1 = *(const LAS f32x4*)(wr_ + 4);
                d[0] += v[j][e] * w0[0]; d[1] += v[j][e] * w0[1]; d[2] += v[j][e] * w0[2]; d[3] += v[j][e] * w0[3];
                d[4] += v[j][e] * w1[0]; d[5] += v[j][e] * w1[1]; d[6] += v[j][e] * w1[2]; d[7] += v[j][e] * w1[3]; } }
#pragma unroll
        for (int q = 0; q < 8; ++q) d[q] = wave_sum(d[q]);
        if (F.lane == 0) { *(f32x4*)(DT + (size_t)m * 8) = (f32x4){d[0], d[1], d[2], d[3]}; *(f32x4*)(DT + (size_t)m * 8 + 4) = (f32x4){d[4], d[5], d[6], d[7]}; }
        const float* prow = m < MP ? A->in[I_PP] + (size_t)m * DPLE : A->in[I_PS] + (size_t)(m - MP) * DPLE;
        const f32x4 pv = ((const f32x4*)prow)[F.lane];
        ((unsigned long long*)(PE + (size_t)m * DPLE))[F.lane] = (unsigned long long)pk2(pv[0], pv[1]) | ((unsigned long long)pk2(pv[2], pv[3]) << 32);
    }
}
__device__ __forceinline__ void p9_final_ln(const Frame& F, CArgs A) {
    const int gw = F.vcu * NWAVES + F.wave, NGW = F.G * NWAVES;
    f32x4 gv[4], bv[4];
#pragma unroll
    for (int j = 0; j < 4; ++j) { gv[j] = ((const f32x4*)A->in[I_LN3G])[F.lane + 64 * j]; bv[j] = ((const f32x4*)A->in[I_LN3B])[F.lane + 64 * j]; }
    for (int m = gw; m < M; m += NGW) {
        f32x4* yrow = (f32x4*)(A->out + O_Y + (size_t)m * DM);
        f32x4 v[4]; float s = 0.f;
#pragma unroll
        for (int j = 0; j < 4; ++j) { v[j] = yrow[F.lane + 64 * j]; s += (v[j][0] + v[j][1]) + (v[j][2] + v[j][3]); }
        const float mean = wave_sum(s) * (1.f / DM); float s2 = 0.f;
#pragma unroll
        for (int j = 0; j < 4; ++j) { v[j] = v[j] - mean; s2 += (v[j][0] * v[j][0] + v[j][1] * v[j][1]) + (v[j][2] * v[j][2] + v[j][3] * v[j][3]); }
        const float rstd = 1.f / sqrtf(wave_sum(s2) * (1.f / DM) + LN_EPS);
#pragma unroll
        for (int j = 0; j < 4; ++j) yrow[F.lane + 64 * j] = v[j] * rstd * gv[j] + bv[j];
    }
}
constexpr float C1 = 0.125f * LOG2E;
constexpr int VST_STRIDE = 144, VST_BYTES = 32 * VST_STRIDE;
typedef short v4i16_t __attribute__((ext_vector_type(4)));
__device__ __forceinline__ s16x4 vtr(const LAS unsigned char* p) { return __builtin_bit_cast(s16x4, __builtin_amdgcn_ds_read_tr16_b64_v4i16((LAS v4i16_t*)p)); }
#define MFMA32(a, b, c) __builtin_amdgcn_mfma_f32_32x32x16_bf16((a), (b), (c), 0, 0, 0)
__device__ __forceinline__ void attn_tile_core(float& m, float& l, f32x16& o0, f32x16& o1, const bf16x8 (&qf)[4], const bf16x8 (&kf)[4], const LAS unsigned char* vst, const f32x16 bias, int lane) {
    const int hi = lane >> 5;
    f32x16 S = bias;
#pragma unroll
    for (int s = 0; s < 4; ++s) S = MFMA32(kf[s], qf[s], S);
    float mt = -INFINITY;
#pragma unroll
    for (int r = 0; r < 16; ++r) { S[r] = S[r] * C1; mt = fmaxf(mt, S[r]); }
    mt = fmaxf(mt, __shfl_xor(mt, 32));
    const float mn = fmaxf(fmaxf(m, mt), -3.0e38f);
    const float sc = fast_exp2(m - mn);
    float ps = 0.f;
#pragma unroll
    for (int r = 0; r < 16; ++r) { S[r] = fast_exp2(S[r] - mn); ps += S[r]; }
    l = l * sc + ps;
    if (__any(mn > m)) {
#pragma unroll
        for (int r = 0; r < 16; ++r) { o0[r] *= sc; o1[r] *= sc; } }
    m = mn;
    const bf16x8 pf0 = pack8(S[0], S[1], S[2], S[3], S[4], S[5], S[6], S[7]), pf1 = pack8(S[8], S[9], S[10], S[11], S[12], S[13], S[14], S[15]);
    const LAS unsigned char* vb = vst + (4 * hi + ((lane >> 2) & 3)) * VST_STRIDE + (16 * ((lane >> 4) & 1) + 4 * (lane & 3)) * 2;
    asm volatile("s_waitcnt lgkmcnt(0)" ::: "memory");
    s16x4 a, b; bf16x8 vf;
    a = vtr(vb); b = vtr(vb + 8 * VST_STRIDE); vf = (bf16x8){a[0], a[1], a[2], a[3], b[0], b[1], b[2], b[3]}; o0 = MFMA32(vf, pf0, o0);
    a = vtr(vb + 64); b = vtr(vb + 8 * VST_STRIDE + 64); vf = (bf16x8){a[0], a[1], a[2], a[3], b[0], b[1], b[2], b[3]}; o1 = MFMA32(vf, pf0, o1);
    a = vtr(vb + 16 * VST_STRIDE); b = vtr(vb + 24 * VST_STRIDE); vf = (bf16x8){a[0], a[1], a[2], a[3], b[0], b[1], b[2], b[3]}; o0 = MFMA32(vf, pf1, o0);
    a = vtr(vb + 16 * VST_STRIDE + 64); b = vtr(vb + 24 * VST_STRIDE + 64); vf = (bf16x8){a[0], a[1], a[2], a[3], b[0], b[1], b[2], b[3]}; o1 = MFMA32(vf, pf1, o1);
    asm volatile("s_waitcnt lgkmcnt(0)" ::: "memory");
}
template <int GW> struct Grp { int tid, wave, lane; volatile LAS unsigned* cnt; unsigned target;
    __device__ __forceinline__ void sync() {
        if (GW == 8) { __syncthreads(); }
        else { asm volatile("s_waitcnt vmcnt(0) lgkmcnt(0)" ::: "memory"); target += GW;
            if (lane == 0) __hip_atomic_fetch_add((LAS unsigned*)cnt, 1u, __ATOMIC_RELAXED, __HIP_MEMORY_SCOPE_WORKGROUP);
            while (__hip_atomic_load((LAS unsigned*)cnt, __ATOMIC_RELAXED, __HIP_MEMORY_SCOPE_WORKGROUP) < target) __builtin_amdgcn_s_sleep(1);
            asm volatile("" ::: "memory"); } } };
constexpr int AT_OR = 0, AT_ORS = 136, AT_ML = 512 * AT_ORS, AT_VST = AT_ML + 4096;
template <int GW> constexpr int at_bytes() { return AT_VST + GW * 2 * VST_BYTES; }
struct KVt { v4u k[4]; v4u v[4]; };
__device__ __forceinline__ void kv_load(KVt& t, const bf16* __restrict__ PROJ, size_t rb, int h, int r, int dil, int gk0, int lane) {
    const bf16* p = PROJ + (rb + r + (size_t)dil * (gk0 + (lane >> 3))) * NPROJ + h * HD + 8 * (lane & 7);
    const size_t step = (size_t)dil * 8 * NPROJ;
#pragma unroll
    for (int s = 0; s < 4; ++s) { t.k[s] = *(const v4u*)(p + s * step + CK); t.v[s] = *(const v4u*)(p + s * step + CV); }
}
template <int GW>
__device__ __forceinline__ void attn_prompt_unit(Grp<GW>& G, LAS unsigned char* lds, const bf16* __restrict__ PROJ, bf16* __restrict__ MIX, int b, int h, int blk) {
    const int lane = G.lane, q = lane & 31, hi = lane >> 5;
    LAS unsigned char* vst = lds + AT_VST + G.wave * 2 * VST_BYTES; LAS unsigned char* kst = vst + VST_BYTES;
    const float slope2 = fast_exp2(-(float)(h + 1)) * LOG2E;
    const size_t rb = (size_t)b * SEQ;
#pragma unroll 1
    for (int br = 0; br < 3; ++br) {
        const int dil = 1 << (2 * br);
#pragma unroll 1
        for (int j2 = 0; j2 < 16 / GW; ++j2) {
            const int qt = G.wave * (16 / GW) + j2;
            int r, i0;
            if (br == 0) { r = 0; i0 = qt * 32; } else if (br == 1) { r = qt >> 2; i0 = (qt & 3) * 32; } else { r = qt; i0 = 0; }
            const int qloc = r + dil * (i0 + q);
            const int gq0 = (blk * 512) / dil + i0;
            int jt = 4 - (gq0 >> 5); jt = jt < 0 ? 0 : jt;
            KVt cur; kv_load(cur, PROJ, rb, h, r, dil, gq0 - 128 + 32 * jt, lane);
            const bf16* qp = PROJ + (rb + blk * 512 + qloc) * NPROJ + CQ + h * HD + 8 * hi;
            bf16x8 qf[4];
#pragma unroll
            for (int s = 0; s < 4; ++s) qf[s] = *(const bf16x8*)(qp + 16 * s);
            float m, l; f32x16 o0, o1;
            LAS unsigned char* orow = lds + AT_OR + qloc * AT_ORS + 8 * hi;
            LAS float* ml = (LAS float*)(lds + AT_ML) + 2 * qloc;
            if (br == 0) { m = -INFINITY; l = 0.f;
#pragma unroll
                for (int k = 0; k < 16; ++k) { o0[k] = 0.f; o1[k] = 0.f; } }
            else { m = ml[0]; l = hi ? 0.f : ml[1];
#pragma unroll
                for (int g = 0; g < 4; ++g) { const v2u w0 = *(const LAS v2u*)(orow + 16 * g), w1 = *(const LAS v2u*)(orow + 64 + 16 * g);
                    o0[4 * g] = bflo(w0.x); o0[4 * g + 1] = bfhi(w0.x); o0[4 * g + 2] = bflo(w0.y); o0[4 * g + 3] = bfhi(w0.y);
                    o1[4 * g] = bflo(w1.x); o1[4 * g + 1] = bfhi(w1.x); o1[4 * g + 2] = bflo(w1.y); o1[4 * g + 3] = bfhi(w1.y); } }
            const float sd = slope2 * (float)dil * (1.0f / C1);
#pragma unroll 1
            for (; jt < 5; ++jt) {
                KVt nxt;
                if (jt < 4) kv_load(nxt, PROJ, rb, h, r, dil, gq0 - 128 + 32 * (jt + 1), lane);
                { const int wo = (lane >> 3) * VST_STRIDE + 16 * (lane & 7);
#pragma unroll
                  for (int s = 0; s < 4; ++s) { *(LAS v4u*)(vst + wo + s * 8 * VST_STRIDE) = cur.v[s]; *(LAS v4u*)(kst + wo + s * 8 * VST_STRIDE) = cur.k[s]; } }
                bf16x8 kf[4];
                asm volatile("s_waitcnt lgkmcnt(0)" ::: "memory");
#pragma unroll
                for (int s = 0; s < 4; ++s) kf[s] = *(const LAS bf16x8*)(kst + q * VST_STRIDE + 32 * s + 16 * hi);
                f32x16 bias; int q_ = q; asm volatile("" : "+v"(q_));
                { const float base = -sd * (float)(128 - 32 * jt + q_ - 4 * hi); const int lo = (jt == 0) ? q_ - 4 * hi : -1000, up = (jt == 4) ? q_ - 4 * hi : 1000;
#pragma unroll
                  for (int rr = 0; rr < 16; ++rr) { const int kv0 = crow(rr, 0); const float b = base + sd * (float)kv0; bias[rr] = (kv0 >= lo && kv0 <= up) ? b : -INFINITY; } }
                attn_tile_core(m, l, o0, o1, qf, kf, vst, bias, lane);
                if (jt < 4) cur = nxt;
            }
            l += __shfl_xor(l, 32);
            if (br < 2) {
                if (hi == 0) { ml[0] = m; ml[1] = l; }
#pragma unroll
                for (int g = 0; g < 4; ++g) { v2u w0, w1; w0.x = pk2(o0[4 * g], o0[4 * g + 1]); w0.y = pk2(o0[4 * g + 2], o0[4 * g + 3]); w1.x = pk2(o1[4 * g], o1[4 * g + 1]); w1.y = pk2(o1[4 * g + 2], o1[4 * g + 3]);
                    *(LAS v2u*)(orow + 16 * g) = w0; *(LAS v2u*)(orow + 64 + 16 * g) = w1; }
            } else {
                const float inv = 1.0f / l;
                bf16* op = MIX + (rb + blk * 512 + qloc) * DM + h * HD + 4 * hi;
#pragma unroll
                for (int g = 0; g < 4; ++g) { v2u w0, w1; w0.x = pk2(o0[4 * g] * inv, o0[4 * g + 1] * inv); w0.y = pk2(o0[4 * g + 2] * inv, o0[4 * g + 3] * inv);
                    w1.x = pk2(o1[4 * g] * inv, o1[4 * g + 1] * inv); w1.y = pk2(o1[4 * g + 2] * inv, o1[4 * g + 3] * inv);
                    *(v2u*)(op + 8 * g) = w0; *(v2u*)(op + 32 + 8 * g) = w1; }
            }
        }
        G.sync();
    }
}
__device__ __forceinline__ int as_pos(int t, int j) { return t < 24 ? 16 * (4 * t + (j >> 3)) + (j & 7) : (t < 40 ? 1536 + 32 * (t - 24) + j : WBUF + j); }
struct KVs { f32x4 k[8]; f32x4 v[8]; };
__device__ __forceinline__ void kvs_load(KVs& t_, const float* __restrict__ cache_k, const float* __restrict__ cache_v, int n, int h, int t, int lane) {
    const int pk = as_pos(t, lane & 31), pv = as_pos(t, lane >> 1);
    const float* kp = cache_k + (((size_t)n * WBUF + pk) * NH + h) * HD + 8 * (lane >> 5);
    const float* vp = cache_v + (((size_t)n * WBUF + pv) * NH + h) * HD + 32 * (lane & 1);
#pragma unroll
    for (int s = 0; s < 4; ++s) { t_.k[2 * s] = __builtin_nontemporal_load((const f32x4*)(kp + 16 * s)); t_.k[2 * s + 1] = __builtin_nontemporal_load((const f32x4*)(kp + 16 * s + 4)); }
#pragma unroll
    for (int s = 0; s < 8; ++s) t_.v[s] = __builtin_nontemporal_load((const f32x4*)(vp + 4 * s));
}
__device__ __forceinline__ f32x16 as_bias(int t, int hi, int qi, float slope2) {
    asm volatile("" : "+v"(qi));
    f32x16 bias;
#pragma unroll
    for (int rr = 0; rr < 16; ++rr) { const int p = as_pos(t, crow(rr, hi)); const int d = WBUF + qi - p;
        const int mult = (d >= 0) ? ((d <= 128 ? 1 : 0) + (((d & 3) == 0 && d <= 512) ? 1 : 0) + (((d & 15) == 0 && d <= 2048) ? 1 : 0)) : 0;
        const float lm = (mult == 3) ? 1.5849625007211562f : ((mult == 2) ? 1.0f : 0.0f);
        bias[rr] = mult ? (lm - slope2 * (float)d) * (1.0f / C1) : -INFINITY; }
    return bias;
}
constexpr int AS_WAVE_BYTES = VST_BYTES + 4096;
__device__ __forceinline__ void attn_sample_task(LAS unsigned char* vst, int lane, const bf16* __restrict__ PROJ, const float* __restrict__ cache_k, const float* __restrict__ cache_v, bf16* __restrict__ MIX, int n, int h) {
    const int q = lane & 31, hi = lane >> 5, qi = q & 7;
    const float slope2 = fast_exp2(-(float)(h + 1)) * LOG2E;
    LAS unsigned char* vw = vst + (lane >> 1) * VST_STRIDE + 64 * (lane & 1);
    LAS bf16x8* qs = (LAS bf16x8*)(vst + VST_BYTES) + lane;
    bf16x8 kf[4];
    { KVs c0; kvs_load(c0, cache_k, cache_v, n, h, 0, lane);
      const bf16* qp = PROJ + (size_t)(MP + n * DECT + qi) * NPROJ + CQ + h * HD + 8 * hi;
#pragma unroll
      for (int s = 0; s < 4; ++s) qs[64 * s] = *(const bf16x8*)(qp + 16 * s);
#pragma unroll
      for (int s = 0; s < 4; ++s) { kf[s] = cvt8(c0.k[2 * s], c0.k[2 * s + 1]); *(LAS bf16x8*)(vw + 16 * s) = cvt8(c0.v[2 * s], c0.v[2 * s + 1]); } }
    float m = -INFINITY, l = 0.f; f32x16 o0, o1;
#pragma unroll
    for (int k = 0; k < 16; ++k) { o0[k] = 0.f; o1[k] = 0.f; }
#pragma unroll 1
    for (int t = 0; t < 39; ++t) {
        KVs nxt; kvs_load(nxt, cache_k, cache_v, n, h, t + 1, lane);
        { bf16x8 qf[4];
#pragma unroll
          for (int s = 0; s < 4; ++s) qf[s] = qs[64 * s];
          attn_tile_core(m, l, o0, o1, qf, kf, vst, as_bias(t, hi, qi, slope2), lane); }
#pragma unroll
        for (int s = 0; s < 4; ++s) { kf[s] = cvt8(nxt.k[2 * s], nxt.k[2 * s + 1]); *(LAS bf16x8*)(vw + 16 * s) = cvt8(nxt.v[2 * s], nxt.v[2 * s + 1]); }
    }
    {
        const bf16* kp = PROJ + (size_t)(MP + n * DECT + (q & 7)) * NPROJ + CK + h * HD + 8 * hi;
        const bf16* vp = PROJ + (size_t)(MP + n * DECT + ((lane >> 1) & 7)) * NPROJ + CV + h * HD + 32 * (lane & 1);
        bf16x8 kn[4], vn[4], qf[4];
#pragma unroll
        for (int s = 0; s < 4; ++s) { kn[s] = *(const bf16x8*)(kp + 16 * s); vn[s] = *(const bf16x8*)(vp + 8 * s); qf[s] = qs[64 * s]; }
        attn_tile_core(m, l, o0, o1, qf, kf, vst, as_bias(39, hi, qi, slope2), lane);
#pragma unroll
        for (int s = 0; s < 4; ++s) *(LAS bf16x8*)(vw + 16 * s) = vn[s];
        attn_tile_core(m, l, o0, o1, qf, kn, vst, as_bias(40, hi, qi, slope2), lane);
    }
    l += __shfl_xor(l, 32);
    const float inv = 1.0f / l;
    if (q < 8) { bf16* op = MIX + (size_t)(MP + n * DECT + q) * DM + h * HD + 4 * hi;
#pragma unroll
        for (int g = 0; g < 4; ++g) { v2u w0, w1; w0.x = pk2(o0[4 * g] * inv, o0[4 * g + 1] * inv); w0.y = pk2(o0[4 * g + 2] * inv, o0[4 * g + 3] * inv);
            w1.x = pk2(o1[4 * g] * inv, o1[4 * g + 1] * inv); w1.y = pk2(o1[4 * g + 2] * inv, o1[4 * g + 3] * inv);
            *(v2u*)(op + 8 * g) = w0; *(v2u*)(op + 32 + 8 * g) = w1; } }
}
constexpr int AS_MRG = NWAVES * VST_BYTES;
__device__ __forceinline__ void attn_sample_task2(const Frame& F, const bf16* __restrict__ PROJ, const float* __restrict__ cache_k, const float* __restrict__ cache_v, bf16* __restrict__ MIX, int n, int h, int half, int pair) {
    const int lane = F.lane, q = lane & 31, hi = lane >> 5, qi = q & 7;
    LAS unsigned char* vst = F.lds + F.wave * VST_BYTES;
    const float slope2 = fast_exp2(-(float)(h + 1)) * LOG2E;
    const bf16* qp = PROJ + (size_t)(MP + n * DECT + qi) * NPROJ + CQ + h * HD + 8 * hi;
    bf16x8 qf[4];
#pragma unroll
    for (int s = 0; s < 4; ++s) qf[s] = *(const bf16x8*)(qp + 16 * s);
    float m = -INFINITY, l = 0.f; f32x16 o0, o1;
#pragma unroll
    for (int k = 0; k < 16; ++k) { o0[k] = 0.f; o1[k] = 0.f; }
    const int t0 = half ? 21 : 0, t1 = half ? 41 : 21;
#pragma unroll 1
    for (int t = t0; t < t1; ++t) {
        bf16x8 kf[4];
        LAS unsigned char* vw = vst + (lane >> 1) * VST_STRIDE + 64 * (lane & 1);
        if (t < 40) {
            const int pk = as_pos(t, q), pv = as_pos(t, lane >> 1);
            const float* kp = cache_k + (((size_t)n * WBUF + pk) * NH + h) * HD + 8 * hi;
            const float* vp = cache_v + (((size_t)n * WBUF + pv) * NH + h) * HD + 32 * (lane & 1);
            f32x4 kk[8], vv[8];
#pragma unroll
            for (int s = 0; s < 4; ++s) { kk[2 * s] = *(const f32x4*)(kp + 16 * s); kk[2 * s + 1] = *(const f32x4*)(kp + 16 * s + 4); }
#pragma unroll
            for (int s = 0; s < 8; ++s) vv[s] = *(const f32x4*)(vp + 4 * s);
#pragma unroll
            for (int s = 0; s < 4; ++s) kf[s] = cvt8(kk[2 * s], kk[2 * s + 1]);
#pragma unroll
            for (int s = 0; s < 4; ++s) *(LAS bf16x8*)(vw + 16 * s) = cvt8(vv[2 * s], vv[2 * s + 1]);
        } else {
            const bf16* kp = PROJ + (size_t)(MP + n * DECT + (q & 7)) * NPROJ + CK + h * HD + 8 * hi;
            const bf16* vp = PROJ + (size_t)(MP + n * DECT + ((lane >> 1) & 7)) * NPROJ + CV + h * HD + 32 * (lane & 1);
#pragma unroll
            for (int s = 0; s < 4; ++s) kf[s] = *(const bf16x8*)(kp + 16 * s);
#pragma unroll
            for (int s = 0; s < 4; ++s) *(LAS v4u*)(vw + 16 * s) = *(const v4u*)(vp + 8 * s);
        }
        attn_tile_core(m, l, o0, o1, qf, kf, vst, as_bias(t, hi, qi, slope2), lane);
    }
    l += __shfl_xor(l, 32);
    LAS float* mg = (LAS float*)(F.lds + AS_MRG) + pair * 34 * 64 + lane;
    if (half) { mg[0] = m; mg[64] = l;
#pragma unroll
        for (int k = 0; k < 16; ++k) { mg[(2 + k) * 64] = o0[k]; mg[(18 + k) * 64] = o1[k]; } }
    __syncthreads();
    if (!half) {
        const float m2 = mg[0], l2 = mg[64]; const float mn = fmaxf(fmaxf(m, m2), -3.0e38f); const float a = fast_exp2(m - mn), c = fast_exp2(m2 - mn);
        const float inv = 1.0f / (l * a + l2 * c);
#pragma unroll
        for (int k = 0; k < 16; ++k) { o0[k] = (o0[k] * a + mg[(2 + k) * 64] * c) * inv; o1[k] = (o1[k] * a + mg[(18 + k) * 64] * c) * inv; }
        if (q < 8) { bf16* op = MIX + (size_t)(MP + n * DECT + q) * DM + h * HD + 4 * hi;
#pragma unroll
            for (int g = 0; g < 4; ++g) { v2u w0, w1; w0.x = pk2(o0[4 * g], o0[4 * g + 1]); w0.y = pk2(o0[4 * g + 2], o0[4 * g + 3]); w1.x = pk2(o1[4 * g], o1[4 * g + 1]); w1.y = pk2(o1[4 * g + 2], o1[4 * g + 3]);
                *(v2u*)(op + 8 * g) = w0; *(v2u*)(op + 32 + 8 * g) = w1; } }
    }
    __syncthreads();
}
constexpr int SROW = 272;
__device__ __forceinline__ float softplusf_(float x) { return x > 20.f ? x : log1pf(__expf(x)); }
__device__ __forceinline__ void ssd_dt_scan(int wave, int lane, CArgs A, const float* __restrict__ DT, int row0, int g, LAS float* acs, LAS float* dtv, LAS float* atl) {
    if (wave < 4) {
        const int hh = wave, h = 4 * g + hh;
        const float dtb = A->in[I_DTB][h], a = -__expf(A->in[I_ALOG][h]);
        const float d0 = softplusf_(DT[(size_t)(row0 + lane) * 8 + h] + dtb), d1 = softplusf_(DT[(size_t)(row0 + 64 + lane) * 8 + h] + dtb);
        float c0 = d0 * a, c1 = d1 * a;
#pragma unroll
        for (int o = 1; o < 64; o <<= 1) { const float t0 = __shfl_up(c0, o), t1 = __shfl_up(c1, o); if (lane >= o) { c0 += t0; c1 += t1; } }
        c1 += __shfl(c0, 63);
        acs[hh * 128 + lane] = c0; acs[hh * 128 + 64 + lane] = c1; dtv[hh * 128 + lane] = d0; dtv[hh * 128 + 64 + lane] = d1;
        if (lane == 63) atl[hh] = c1;
    }
}
struct Conv8 { f32x4 w[4][2]; f32x4 b[2]; };
__device__ __forceinline__ void conv8_load(Conv8& c, const float* __restrict__ cw, const float* __restrict__ cb, int cidx) {
#pragma unroll
    for (int w = 0; w < 4; ++w) { c.w[w][0] = *(const f32x4*)(cw + w * CONVD + cidx); c.w[w][1] = *(const f32x4*)(cw + w * CONVD + cidx + 4); }
    c.b[0] = *(const f32x4*)(cb + cidx); c.b[1] = *(const f32x4*)(cb + cidx + 4);
}
struct Row8 { f32x4 a, b; };
__device__ __forceinline__ Row8 row8_from(const v4u r) { Row8 o; o.a = (f32x4){bflo(r.x), bfhi(r.x), bflo(r.y), bfhi(r.y)}; o.b = (f32x4){bflo(r.z), bfhi(r.z), bflo(r.w), bfhi(r.w)}; return o; }
__device__ __forceinline__ Row8 conv8_silu(const Conv8& c, const Row8& x3, const Row8& x2, const Row8& x1, const Row8& x0) {
    Row8 o; o.a = c.b[0] + c.w[0][0] * x3.a + c.w[1][0] * x2.a + c.w[2][0] * x1.a + c.w[3][0] * x0.a; o.b = c.b[1] + c.w[0][1] * x3.b + c.w[1][1] * x2.b + c.w[2][1] * x1.b + c.w[3][1] * x0.b;
#pragma unroll
    for (int k = 0; k < 4; ++k) { o.a[k] = siluf_(o.a[k]); o.b[k] = siluf_(o.b[k]); }
    return o;
}
constexpr int SS_XT = 0, SS_B = 256 * SROW, SS_C = SS_B + 128 * SROW, SS_ACS = SS_C + 128 * SROW, SS_DTV = SS_ACS + 2048, SS_ATL = SS_DTV + 2048, SS_SS = SS_ATL + 128, SS_END = SS_SS + 2048;
static_assert(SS_END <= RING_BYTES, "SSD LDS map");
constexpr int ST_XT = 0, ST_B = 256 * SROW, ST_ACS = ST_B + 128 * SROW, ST_DTV = ST_ACS + 2048, ST_ATL = ST_DTV + 2048, ST_END = ST_ATL + 128;
template <int GW>
__device__ __forceinline__ void ssd_states_unit(Grp<GW>& G, LAS unsigned char* lds, CArgs A, int b, int c, int g) {
    unsigned char* ws = A->ws; const bf16* __restrict__ PROJ = (const bf16*)(ws + WS_PROJ); const float* DT = (const float*)(ws + WS_DT);
    float* STLOC = (float*)(ws + WS_STLOC); float* ATOT = (float*)(ws + WS_ATOT);
    const int row0 = b * SEQ + c * 128, lane = G.lane, hi = lane >> 5;
    LAS float* acs = (LAS float*)(lds + ST_ACS); LAS float* dtv = (LAS float*)(lds + ST_DTV); LAS float* atl = (LAS float*)(lds + ST_ATL);
    ssd_dt_scan(G.wave, lane, A, DT, row0, g, acs, dtv, atl);
    G.sync();
#pragma unroll 1
    for (int it = G.tid; it < 384; it += GW * 64) {
        const int cg = it % 48, lseg = it / 48; const bool isx = cg < 32; const int hh = cg >> 3;
        const int cidx = isx ? g * 256 + cg * 8 : 512 + g * 128 + (cg - 32) * 8;
        Conv8 cv; conv8_load(cv, A->in[I_CONVW], A->in[I_CONVB], cidx);
        const int l0 = 16 * lseg; const bf16* src = PROJ + (size_t)row0 * NPROJ + CXB + cidx;
        const Row8 zero = {(f32x4){0.f, 0.f, 0.f, 0.f}, (f32x4){0.f, 0.f, 0.f, 0.f}};
        Row8 x3 = (c * 128 + l0 - 3 >= 0) ? row8_from(*(const v4u*)(src + (ptrdiff_t)(l0 - 3) * NPROJ)) : zero;
        Row8 x2 = (c * 128 + l0 - 2 >= 0) ? row8_from(*(const v4u*)(src + (ptrdiff_t)(l0 - 2) * NPROJ)) : zero;
        Row8 x1 = (c * 128 + l0 - 1 >= 0) ? row8_from(*(const v4u*)(src + (ptrdiff_t)(l0 - 1) * NPROJ)) : zero;
        LAS unsigned char* dst = lds + (isx ? ST_XT + (cg * 8) * SROW : ST_B + ((cg - 32) * 8) * SROW);
        const float at = isx ? atl[hh] : 0.f;
#pragma unroll 4
        for (int li = 0; li < 16; ++li) { const int l = l0 + li;
            const Row8 x0 = row8_from(*(const v4u*)(src + (size_t)l * NPROJ));
            Row8 s = conv8_silu(cv, x3, x2, x1, x0);
            if (isx) { const float f = dtv[hh * 128 + l] * __expf(at - acs[hh * 128 + l]); s.a = s.a * f; s.b = s.b * f; }
#pragma unroll
            for (int k = 0; k < 4; ++k) { *(LAS unsigned short*)(dst + k * SROW + 2 * l) = (unsigned short)f2bf(s.a[k]); *(LAS unsigned short*)(dst + (4 + k) * SROW + 2 * l) = (unsigned short)f2bf(s.b[k]); }
            x3 = x2; x2 = x1; x1 = x0; }
    }
    G.sync();
#pragma unroll 1
    for (int wt = G.wave; wt < 8; wt += GW) {
        const int hh = wt >> 1, ph = wt & 1, h = 4 * g + hh;
        f32x16 acc[4];
#pragma unroll
        for (int nt = 0; nt < 4; ++nt)
#pragma unroll
            for (int k = 0; k < 16; ++k) acc[nt][k] = 0.f;
        const LAS unsigned char* ar = lds + ST_XT + (hh * 64 + 32 * ph + (lane & 31)) * SROW + 16 * hi;
        const LAS unsigned char* brw = lds + ST_B + (lane & 31) * SROW + 16 * hi;
#pragma unroll
        for (int ks = 0; ks < 8; ++ks) { const bf16x8 af = *(const LAS bf16x8*)(ar + 32 * ks);
#pragma unroll
            for (int nt = 0; nt < 4; ++nt) { const bf16x8 bf = *(const LAS bf16x8*)(brw + nt * 32 * SROW + 32 * ks); acc[nt] = MFMA32(af, bf, acc[nt]); } }
        float* o = STLOC + ((size_t)((b * 16 + c) * NH + h) * HD + 32 * ph) * DST + (lane & 31);
#pragma unroll
        for (int nt = 0; nt < 4; ++nt)
#pragma unroll
            for (int k = 0; k < 16; ++k) o[(size_t)crow(k, hi) * DST + 32 * nt] = acc[nt][k];
        if (lane == 0 && ph == 0) ATOT[(b * 16 + c) * NH + h] = atl[hh];
    }
    G.sync();
}
__device__ __forceinline__ void ssd_scan_unit(const Frame& F, CArgs A, int unit) {
    const int bh = unit >> 2, pq = unit & 3, b = bh >> 3, h = bh & 7;
    float* STLOC = (float*)(A->ws + WS_STLOC); const float* ATOT = (const float*)(A->ws + WS_ATOT);
    const int p = 16 * pq + (F.tid >> 5), n4 = (F.tid & 31) * 4;
    f32x4 s = {0.f, 0.f, 0.f, 0.f};
#pragma unroll 4
    for (int c = 0; c < 16; ++c) { f32x4* slot = (f32x4*)(STLOC + ((size_t)((b * 16 + c) * NH + h) * HD + p) * DST + n4);
        const f32x4 loc = *slot; *slot = s; s = s * __expf(ATOT[(b * 16 + c) * NH + h]) + loc; }
    *(f32x4*)(A->out + O_SP + ((size_t)(b * NH + h) * HD + p) * DST + n4) = s;
}
__device__ __forceinline__ void ssd_out_unit(const Frame& F, CArgs A, int b, int c, int g) {
    unsigned char* ws = A->ws; const bf16* __restrict__ PROJ = (const bf16*)(ws + WS_PROJ); const float* DT = (const float*)(ws + WS_DT);
    const float* STLOC = (const float*)(ws + WS_STLOC); bf16* MIX = (bf16*)(ws + WS_MIX);
    const int row0 = b * SEQ + c * 128, lane = F.lane, hi = lane >> 5;
    LAS float* acs = (LAS float*)(F.lds + SS_ACS); LAS float* dtv = (LAS float*)(F.lds + SS_DTV); LAS float* atl = (LAS float*)(F.lds + SS_ATL); LAS float* ssq = (LAS float*)(F.lds + SS_SS);
    ssd_dt_scan(F.wave, F.lane, A, DT, row0, g, acs, dtv, atl);
    {
        const int cg = F.tid & 63, lseg = F.tid >> 6; const int kind = cg < 32 ? 0 : (cg < 48 ? 1 : 2);
        const int cidx = kind == 0 ? g * 256 + cg * 8 : (kind == 1 ? 512 + g * 128 + (cg - 32) * 8 : 768 + g * 128 + (cg - 48) * 8);
        Conv8 cv; conv8_load(cv, A->in[I_CONVW], A->in[I_CONVB], cidx);
        const int l0 = 16 * lseg; const bf16* src = PROJ + (size_t)row0 * NPROJ + CXB + cidx;
        const Row8 zero = {(f32x4){0.f, 0.f, 0.f, 0.f}, (f32x4){0.f, 0.f, 0.f, 0.f}};
        Row8 x3 = (c * 128 + l0 - 3 >= 0) ? row8_from(*(const v4u*)(src + (ptrdiff_t)(l0 - 3) * NPROJ)) : zero;
        Row8 x2 = (c * 128 + l0 - 2 >= 0) ? row8_from(*(const v4u*)(src + (ptrdiff_t)(l0 - 2) * NPROJ)) : zero;
        Row8 x1 = (c * 128 + l0 - 1 >= 0) ? row8_from(*(const v4u*)(src + (ptrdiff_t)(l0 - 1) * NPROJ)) : zero;
        LAS unsigned char* dstx = F.lds + SS_XT + (cg * 8) * SROW;
        LAS unsigned char* dstn = F.lds + (kind == 1 ? SS_B + (cg - 32) * 16 : SS_C + (cg - 48) * 16);
#pragma unroll 4
        for (int li = 0; li < 16; ++li) { const int l = l0 + li;
            const Row8 x0 = row8_from(*(const v4u*)(src + (size_t)l * NPROJ));
            const Row8 s = conv8_silu(cv, x3, x2, x1, x0);
            if (kind == 0) {
#pragma unroll
                for (int k = 0; k < 4; ++k) { *(LAS unsigned short*)(dstx + k * SROW + 2 * l) = (unsigned short)f2bf(s.a[k]); *(LAS unsigned short*)(dstx + (4 + k) * SROW + 2 * l) = (unsigned short)f2bf(s.b[k]); }
            } else *(LAS bf16x8*)(dstn + l * SROW) = cvt8(s.a, s.b);
            x3 = x2; x2 = x1; x1 = x0; }
    }
    __syncthreads();
    const int hh = F.wave >> 1, lh = F.wave & 1, h = 4 * g + hh;
    f32x16 acc[2][2];
#pragma unroll
    for (int i = 0; i < 2; ++i)
#pragma unroll
        for (int j = 0; j < 2; ++j)
#pragma unroll
            for (int k = 0; k < 16; ++k) acc[i][j][k] = 0.f;
    const LAS unsigned char* cn = F.lds + SS_C + (lane & 31) * SROW + 16 * hi;
    const LAS unsigned char* bn = F.lds + SS_B + (lane & 31) * SROW + 16 * hi;
    {
        const float* sp = STLOC + ((size_t)((b * 16 + c) * NH + h) * HD + (lane & 31)) * DST + 8 * hi;
#pragma unroll 2
        for (int ks = 0; ks < 8; ++ks) {
            const bf16x8 cf0 = *(const LAS bf16x8*)(cn + (64 * lh) * SROW + 32 * ks), cf1 = *(const LAS bf16x8*)(cn + (64 * lh + 32) * SROW + 32 * ks);
#pragma unroll
            for (int pt = 0; pt < 2; ++pt) { const float* s_ = sp + (size_t)(32 * pt) * DST + 16 * ks; const bf16x8 af = cvt8(*(const f32x4*)s_, *(const f32x4*)(s_ + 4));
                acc[0][pt] = MFMA32(af, cf0, acc[0][pt]); acc[1][pt] = MFMA32(af, cf1, acc[1][pt]); } }
#pragma unroll
        for (int lt2 = 0; lt2 < 2; ++lt2) { const float e = __expf(acs[hh * 128 + 64 * lh + 32 * lt2 + (lane & 31)]);
#pragma unroll
            for (int pt = 0; pt < 2; ++pt)
#pragma unroll
                for (int k = 0; k < 16; ++k) acc[lt2][pt][k] *= e; }
    }
    const float dsk = A->in[I_DSKIP][h];
#pragma unroll
    for (int lt2 = 0; lt2 < 2; ++lt2) {
        const int lt = 2 * lh + lt2, lcol = 32 * lt + (lane & 31); const float acs_l = acs[hh * 128 + lcol];
#pragma unroll 1
        for (int st = 0; st <= lt; ++st) {
            f32x16 X;
#pragma unroll
            for (int k = 0; k < 16; ++k) X[k] = 0.f;
#pragma unroll
            for (int ks = 0; ks < 8; ++ks) { const bf16x8 bnf = *(const LAS bf16x8*)(bn + (32 * st) * SROW + 32 * ks), cnf = *(const LAS bf16x8*)(cn + (32 * lt) * SROW + 32 * ks); X = MFMA32(bnf, cnf, X); }
#pragma unroll
            for (int k = 0; k < 16; ++k) { const int s = 32 * st + crow(k, hi); const float as = acs[hh * 128 + s], dts = dtv[hh * 128 + s];
                X[k] = (s <= lcol) ? X[k] * __expf(fminf(acs_l - as, 0.f)) * dts : 0.f; }
            const bf16x8 pf0 = pack8(X[0], X[1], X[2], X[3], X[4], X[5], X[6], X[7]), pf1 = pack8(X[8], X[9], X[10], X[11], X[12], X[13], X[14], X[15]);
#pragma unroll
            for (int pt = 0; pt < 2; ++pt) { const LAS unsigned char* xr = F.lds + SS_XT + (hh * 64 + 32 * pt + (lane & 31)) * SROW + 64 * st + 8 * hi;
                v2u a0 = *(const LAS v2u*)(xr), a1 = *(const LAS v2u*)(xr + 16), b0 = *(const LAS v2u*)(xr + 32), b1 = *(const LAS v2u*)(xr + 48);
                const bf16x8 xf0 = __builtin_bit_cast(bf16x8, (v4u){a0.x, a0.y, a1.x, a1.y}), xf1 = __builtin_bit_cast(bf16x8, (v4u){b0.x, b0.y, b1.x, b1.y});
                acc[lt2][pt] = MFMA32(xf0, pf0, acc[lt2][pt]); acc[lt2][pt] = MFMA32(xf1, pf1, acc[lt2][pt]); }
        }
        float ss = 0.f;
#pragma unroll
        for (int pt = 0; pt < 2; ++pt)
#pragma unroll
            for (int rg = 0; rg < 4; ++rg) { const v2u zw = *(const v2u*)(PROJ + (size_t)(row0 + lcol) * NPROJ + CZ + h * HD + 32 * pt + 8 * rg + 4 * hi);
                const float z[4] = {bflo(zw.x), bfhi(zw.x), bflo(zw.y), bfhi(zw.y)};
#pragma unroll
                for (int e = 0; e < 4; ++e) { const int k = 4 * rg + e; const float xv = bf2f(*(const LAS unsigned short*)(F.lds + SS_XT + (hh * 64 + 32 * pt + crow(k, hi)) * SROW + 2 * lcol));
                    const float y = (acc[lt2][pt][k] + dsk * xv) * siluf_(z[e]); acc[lt2][pt][k] = y; ss += y * y; } }
        ss += __shfl_xor(ss, 32);
        if (hi == 0) ssq[hh * 128 + lcol] = ss;
    }
    __syncthreads();
#pragma unroll
    for (int lt2 = 0; lt2 < 2; ++lt2) {
        const int lcol = 32 * (2 * lh + lt2) + (lane & 31);
        const float tot = (ssq[lcol] + ssq[128 + lcol]) + (ssq[256 + lcol] + ssq[384 + lcol]); const float rstd = 1.0f / sqrtf(tot * (1.0f / 256.0f) + LN_EPS);
#pragma unroll
        for (int pt = 0; pt < 2; ++pt)
#pragma unroll
            for (int rg = 0; rg < 4; ++rg) { const int ch = h * HD + 32 * pt + 8 * rg + 4 * hi; const f32x4 nw = *(const f32x4*)(A->in[I_NORMW] + ch);
                v2u w; w.x = pk2(acc[lt2][pt][4 * rg] * rstd * nw[0], acc[lt2][pt][4 * rg + 1] * rstd * nw[1]); w.y = pk2(acc[lt2][pt][4 * rg + 2] * rstd * nw[2], acc[lt2][pt][4 * rg + 3] * rstd * nw[3]);
                *(v2u*)(MIX + (size_t)(row0 + lcol) * DM + 512 + ch) = w; }
    }
    __syncthreads();
}
constexpr int SP_XS = 0, SP_BS = 8192, SP_CS = 12288, SP_DTS = 16384, SP_ACS = 16512, SP_CB = 16640, SP_YOFF = 16896, SP_YV = 25088, SP_END = 33280;
template <int GW>
__device__ __forceinline__ void ssd_sample_unit(Grp<GW>& G, LAS unsigned char* lds, CArgs A, int n, int g) {
    unsigned char* ws = A->ws; const bf16* __restrict__ PROJ = (const bf16*)(ws + WS_PROJ); const float* DT = (const float*)(ws + WS_DT); bf16* MIX = (bf16*)(ws + WS_MIX);
    LAS float* XS = (LAS float*)(lds + SP_XS); LAS float* BS = (LAS float*)(lds + SP_BS); LAS float* CS_ = (LAS float*)(lds + SP_CS); LAS float* DTS = (LAS float*)(lds + SP_DTS);
    LAS float* ACS = (LAS float*)(lds + SP_ACS); LAS float* CB = (LAS float*)(lds + SP_CB); LAS float* YOFF = (LAS float*)(lds + SP_YOFF); LAS float* YV = (LAS float*)(lds + SP_YV);
    const int lane = G.lane; const int rowb = MP + n * DECT;
#pragma unroll 1
    for (int tid = G.tid; tid < 512; tid += GW * 64) {
        const int kind = tid < 256 ? 0 : (tid < 384 ? 1 : 2);
        const int cidx = kind == 0 ? g * 256 + tid : (kind == 1 ? 512 + g * 128 + (tid - 256) : 768 + g * 128 + (tid - 384));
        const float* cw = A->in[I_CONVW]; const float w0 = cw[cidx], w1 = cw[CONVD + cidx], w2 = cw[2 * CONVD + cidx], w3 = cw[3 * CONVD + cidx], cb = A->in[I_CONVB][cidx];
        const float* sc = A->in[I_SCONV] + (size_t)n * 3 * CONVD + cidx;
        float x3 = sc[0], x2 = sc[CONVD], x1 = sc[2 * CONVD];
        LAS float* dst = kind == 0 ? XS + tid : (kind == 1 ? BS + (tid - 256) : CS_ + (tid - 384)); const int dstride = kind == 0 ? 256 : 128;
#pragma unroll
        for (int l = 0; l < DECT; ++l) { const float x0 = bf2f(PROJ[(size_t)(rowb + l) * NPROJ + CXB + cidx]);
            dst[l * dstride] = siluf_(cb + w0 * x3 + w1 * x2 + w2 * x1 + w3 * x0);
            if (l >= DECT - 3) A->out[O_CS + ((size_t)n * 3 + (l - (DECT - 3))) * CONVD + cidx] = x0;
            x3 = x2; x2 = x1; x1 = x0; }
    }
    { const int tid = G.tid;
        if (tid < 4) { const int h = 4 * g + tid; const float dtb = A->in[I_DTB][h], a = -__expf(A->in[I_ALOG][h]); float cum = 0.f;
#pragma unroll
            for (int l = 0; l < DECT; ++l) { const float d = softplusf_(DT[(size_t)(rowb + l) * 8 + h] + dtb); cum += d * a; DTS[tid * 8 + l] = d; ACS[tid * 8 + l] = cum; } }
    }
    G.sync();
    if (G.wave == 0) {
        const int l = lane >> 3, s = lane & 7; float d = 0.f;
#pragma unroll 8
        for (int k = 0; k < DST; ++k) d += CS_[l * 128 + k] * BS[s * 128 + k];
        CB[lane] = d;
    }
#pragma unroll 1
    for (int wt = G.wave; wt < 8; wt += GW) {
        const int hh = wt >> 1, ph = wt & 1, h = 4 * g + hh, n4 = (lane & 31) * 4, pr = 32 * ph + (lane >> 5);
        const float* h0 = A->in[I_SSSM] + ((size_t)(n * NH + h) * HD + pr) * DST + n4;
        f32x4 H[16], S[16];
#pragma unroll
        for (int k = 0; k < 16; ++k) { H[k] = *(const f32x4*)(h0 + (size_t)(2 * k) * DST); S[k] = (f32x4){0.f, 0.f, 0.f, 0.f}; }
        const float aT = ACS[hh * 8 + 7];
#pragma unroll 1
        for (int l = 0; l < DECT; ++l) {
            const f32x4 c4 = *(const LAS f32x4*)(CS_ + l * 128 + n4), b4 = *(const LAS f32x4*)(BS + l * 128 + n4);
            const float al = ACS[hh * 8 + l], el = __expf(al), f = __expf(aT - al) * DTS[hh * 8 + l];
#pragma unroll
            for (int k = 0; k < 16; ++k) { float d = (c4[0] * H[k][0] + c4[1] * H[k][1]) + (c4[2] * H[k][2] + c4[3] * H[k][3]);
                d += __shfl_xor(d, 1); d += __shfl_xor(d, 2); d += __shfl_xor(d, 4); d += __shfl_xor(d, 8); d += __shfl_xor(d, 16);
                const int p = pr + 2 * k;
                if ((lane & 31) == 0) YOFF[l * 256 + hh * 64 + p] = d * el;
                const float xf = XS[l * 256 + hh * 64 + p] * f; S[k] = S[k] + b4 * xf; }
        }
        const float eT = __expf(aT);
        float* so = A->out + O_SS + ((size_t)(n * NH + h) * HD + pr) * DST + n4;
#pragma unroll
        for (int k = 0; k < 16; ++k) *(f32x4*)(so + (size_t)(2 * k) * DST) = H[k] * eT + S[k];
    }
    G.sync();
#pragma unroll 1
    for (int idx = G.tid; idx < 2048; idx += GW * 64) { const int l = idx >> 8, ch = idx & 255, hh = ch >> 6, h = 4 * g + hh;
        float y = YOFF[idx] + A->in[I_DSKIP][h] * XS[idx]; const float al = ACS[hh * 8 + l];
        for (int s = 0; s <= l; ++s) y += CB[l * 8 + s] * __expf(al - ACS[hh * 8 + s]) * DTS[hh * 8 + s] * XS[s * 256 + ch];
        const float z = bf2f(PROJ[(size_t)(rowb + l) * NPROJ + CZ + g * 256 + ch]);
        YV[idx] = y * siluf_(z); }
    G.sync();
#pragma unroll 1
    for (int l = G.wave; l < 8; l += GW) {
        const f32x4 v = *(const LAS f32x4*)(YV + l * 256 + 4 * lane);
        const float ss = wave_sum((v[0] * v[0] + v[1] * v[1]) + (v[2] * v[2] + v[3] * v[3])); const float rstd = 1.0f / sqrtf(ss * (1.0f / 256.0f) + LN_EPS);
        const f32x4 nw = *(const f32x4*)(A->in[I_NORMW] + g * 256 + 4 * lane);
        v2u w; w.x = pk2(v[0] * rstd * nw[0], v[1] * rstd * nw[1]); w.y = pk2(v[2] * rstd * nw[2], v[3] * rstd * nw[3]);
        *(v2u*)(MIX + (size_t)(rowb + l) * DM + 512 + g * 256 + 4 * lane) = w;
    }
    G.sync();
}
template <int NB, class Epi>
__device__ __forceinline__ void small_gemm_unit(const Frame& F, const bf16* __restrict__ A, const bf16* __restrict__ Bt, int K, int row0, int col0, const Epi& E, int lda = 0, int ldb = 0) {
    if (lda == 0) lda = K; if (ldb == 0) ldb = K;
    constexpr int KS = 8 / NB;
    const int lane = F.lane, r = lane & 15, q = lane >> 4, nb = F.wave % NB, ks = F.wave / NB;
    const int kw = K / KS;
    f32x4 acc[4][4];
#pragma unroll
    for (int i = 0; i < 4; ++i)
#pragma unroll
        for (int j = 0; j < 4; ++j) acc[i][j] = (f32x4){0.f, 0.f, 0.f, 0.f};
    const bf16* ap = A + (size_t)(row0 + r) * lda + ks * kw + 8 * q;
    const bf16* bp = Bt + (size_t)(col0 + nb * 64 + r) * ldb + ks * kw + 8 * q;
    const size_t a16 = (size_t)16 * lda, b16 = (size_t)16 * ldb;
#pragma unroll 4
    for (int kk = 0; kk < kw; kk += 32) {
        bf16x8 a[4], b[4];
#pragma unroll
        for (int i = 0; i < 4; ++i) { a[i] = *(const bf16x8*)(ap + i * a16 + kk); b[i] = *(const bf16x8*)(bp + i * b16 + kk); }
#pragma unroll
        for (int i = 0; i < 4; ++i)
#pragma unroll
            for (int j = 0; j < 4; ++j) acc[i][j] = __builtin_amdgcn_mfma_f32_16x16x32_bf16(a[i], b[j], acc[i][j], 0, 0, 0);
    }
    LAS float* part = (LAS float*)F.lds + (ks * NB + nb) * 4096;
#pragma unroll
    for (int i = 0; i < 4; ++i)
#pragma unroll
        for (int j = 0; j < 4; ++j)
#pragma unroll
            for (int k = 0; k < 4; ++k) part[(16 * i + 4 * q + k) * 64 + 16 * j + r] = acc[i][j][k];
    __syncthreads();
    {
        const int row = F.tid >> 3, c8 = (F.tid & 7) * 8; float s = 0.f, s2 = 0.f;
#pragma unroll
        for (int n = 0; n < NB; ++n) {
            f32x4 a = {0.f, 0.f, 0.f, 0.f}, b = {0.f, 0.f, 0.f, 0.f};
#pragma unroll
            for (int k = 0; k < KS; ++k) { const LAS float* p = (const LAS float*)F.lds + (k * NB + n) * 4096 + row * 64 + c8; a = a + *(const LAS f32x4*)p; b = b + *(const LAS f32x4*)(p + 4); }
            E.row8(row0 + row, col0 + n * 64 + c8, a, b, s, s2);
        }
        if (Epi::STATS) { s += __shfl_xor(s, 1); s += __shfl_xor(s, 2); s += __shfl_xor(s, 4); s2 += __shfl_xor(s2, 1); s2 += __shfl_xor(s2, 2); s2 += __shfl_xor(s2, 4);
            if ((F.tid & 7) == 0) E.flush(row0 + row, s, s2); }
    }
    __syncthreads();
}
constexpr int TG_STRIDE = 144;
template <int TM, int TN, int WM, int WN, int WK, class Epi>
__device__ __forceinline__ void tiled_gemm_unit(const Frame& F, const bf16* __restrict__ A, const bf16* __restrict__ Bt, int K, int row0, int col0, const Epi& E) {
    static_assert(WM * WN * WK == 8 && (TM / WM) % 32 == 0 && (TN / WN) % 32 == 0, "wave grid");
    constexpr int SM = TM / WM / 32, SN = TN / WN / 32;
    constexpr int ROWS = TM + TN, NLD = ROWS * 8 / 512;
    static_assert(ROWS * 8 % 512 == 0, "staging");
    constexpr int STAGE = ROWS * TG_STRIDE;
    static_assert(2 * STAGE <= RING_BYTES && WK * TM * TN * 4 <= RING_BYTES, "LDS");
    const int lane = F.lane, r = lane & 31, hi = lane >> 5;
    const int wm = F.wave % WM, wn = (F.wave / WM) % WN, wk = F.wave / (WM * WN);
    const bf16* gp[NLD]; int lo[NLD];
#pragma unroll
    for (int i = 0; i < NLD; ++i) { const int p = F.tid + 512 * i, rw = p >> 3, pc = p & 7;
        gp[i] = (rw < TM ? A + (size_t)(row0 + rw) * K : Bt + (size_t)(col0 + rw - TM) * K) + 8 * pc; lo[i] = rw * TG_STRIDE + 16 * pc; }
    f32x16 acc[SM][SN];
#pragma unroll
    for (int i = 0; i < SM; ++i)
#pragma unroll
        for (int j = 0; j < SN; ++j)
#pragma unroll
            for (int k = 0; k < 16; ++k) acc[i][j][k] = 0.f;
    v4u st[NLD];
#pragma unroll
    for (int i = 0; i < NLD; ++i) st[i] = *(const v4u*)(gp[i]);
#pragma unroll
    for (int i = 0; i < NLD; ++i) *(LAS v4u*)(F.lds + lo[i]) = st[i];
    __syncthreads();
    const int nch = K / 64;
#pragma unroll 1
    for (int c = 0; c < nch; ++c) {
        const bool more = c + 1 < nch;
        if (more) {
#pragma unroll
            for (int i = 0; i < NLD; ++i) st[i] = *(const v4u*)(gp[i] + (size_t)(c + 1) * 64); }
        const LAS unsigned char* sa = F.lds + (c & 1) * STAGE + (wm * (TM / WM) + r) * TG_STRIDE + 16 * hi;
        const LAS unsigned char* sb = F.lds + (c & 1) * STAGE + (TM + wn * (TN / WN) + r) * TG_STRIDE + 16 * hi;
#pragma unroll
        for (int s = wk * (4 / WK); s < (wk + 1) * (4 / WK); ++s) {
            bf16x8 af[SM], bf[SN];
#pragma unroll
            for (int i = 0; i < SM; ++i) af[i] = *(const LAS bf16x8*)(sa + i * 32 * TG_STRIDE + 32 * s);
#pragma unroll
            for (int j = 0; j < SN; ++j) bf[j] = *(const LAS bf16x8*)(sb + j * 32 * TG_STRIDE + 32 * s);
#pragma unroll
            for (int i = 0; i < SM; ++i)
#pragma unroll
                for (int j = 0; j < SN; ++j) acc[i][j] = MFMA32(af[i], bf[j], acc[i][j]);
        }
        if (more) {
#pragma unroll
            for (int i = 0; i < NLD; ++i) *(LAS v4u*)(F.lds + ((c + 1) & 1) * STAGE + lo[i]) = st[i]; }
        __syncthreads();
    }
    LAS float* ot = (LAS float*)F.lds + wk * TM * TN;
#pragma unroll
    for (int i = 0; i < SM; ++i)
#pragma unroll
        for (int j = 0; j < SN; ++j)
#pragma unroll
            for (int k = 0; k < 16; ++k) ot[(wm * (TM / WM) + 32 * i + crow(k, hi)) * TN + wn * (TN / WN) + 32 * j + r] = acc[i][j][k];
    __syncthreads();
    {
        constexpr int TPR = 512 / TM;
        constexpr int CPT = TN / TPR;
        const int row = F.tid / TPR, cb = (F.tid % TPR) * CPT; float s = 0.f, s2 = 0.f;
#pragma unroll
        for (int n = 0; n < CPT / 8; ++n) {
            const LAS float* p = (const LAS float*)F.lds + row * TN + cb + 8 * n;
            f32x4 a = *(const LAS f32x4*)p, b = *(const LAS f32x4*)(p + 4);
            if (WK == 2) { a = a + *(const LAS f32x4*)(p + TM * TN); b = b + *(const LAS f32x4*)(p + TM * TN + 4); }
            E.row8(row0 + row, col0 + cb + 8 * n, a, b, s, s2);
        }
        if (Epi::STATS) {
#pragma unroll
            for (int o = 1; o < TPR; o <<= 1) { s += __shfl_xor(s, o); s2 += __shfl_xor(s2, o); }
            if ((F.tid % TPR) == 0) E.flush(row0 + row, s, s2); }
    }
    __syncthreads();
}
__device__ __forceinline__ void unpack8f(const v4u w, f32x4& x0, f32x4& x1) { x0 = (f32x4){bflo(w.x), bfhi(w.x), bflo(w.y), bfhi(w.y)}; x1 = (f32x4){bflo(w.z), bfhi(w.z), bflo(w.w), bfhi(w.w)}; }
__device__ __forceinline__ void sums8(const f32x4 a, const f32x4 b, float& s, float& s2) {
    s += (a[0] + a[1]) + (a[2] + a[3]) + (b[0] + b[1]) + (b[2] + b[3]);
    s2 += (a[0] * a[0] + a[1] * a[1]) + (a[2] * a[2] + a[3] * a[3]) + (b[0] * b[0] + b[1] * b[1]) + (b[2] * b[2] + b[3] * b[3]); }
struct RowProj { static constexpr bool STATS = false; bf16* P; float* out;
    __device__ __forceinline__ void row8(int row, int col, f32x4 a, f32x4 b, float&, float&) const {
        *(v4u*)(P + (size_t)row * NPROJ + col) = pack_acc8(a, b);
        if (col >= CK && col < CZ) { const bool isv = col >= CV; float* o = out + (isv ? O_VS : O_KS) + (size_t)(row - MP) * 512 + (col - (isv ? CV : CK)); *(f32x4*)o = a; *(f32x4*)(o + 4) = b; } }
    __device__ __forceinline__ void flush(int, float, float) const {} };
struct RowOut { static constexpr bool STATS = true; const bf16* H0; bf16* V1; float* ST;
    __device__ __forceinline__ void row8(int row, int col, f32x4 a, f32x4 b, float& s, float& s2) const {
        const size_t off = (size_t)row * DM + col; f32x4 x0, x1; unpack8f(*(const v4u*)(H0 + off), x0, x1); a = a + ALPHA * x0; b = b + ALPHA * x1; sums8(a, b, s, s2); *(v4u*)(V1 + off) = pack_acc8(a, b); }
    __device__ __forceinline__ void flush(int row, float s, float s2) const { unsafeAtomicAdd(ST + 2 * row, s); unsafeAtomicAdd(ST + 2 * row + 1, s2); } };
struct RowUp { static constexpr bool STATS = false; bf16* U; const float* ST; const float* cs; const float* bw;
    __device__ __forceinline__ void row8(int row, int col, f32x4 a, f32x4 b, float&, float&) const {
        float mu, rs; row_stats(ST[2 * row], ST[2 * row + 1], mu, rs);
        a = (a - mu * *(const f32x4*)(cs + col)) * rs + *(const f32x4*)(bw + col); b = (b - mu * *(const f32x4*)(cs + col + 4)) * rs + *(const f32x4*)(bw + col + 4);
#pragma unroll
        for (int k = 0; k < 4; ++k) { a[k] = fmaxf(a[k], 0.f); a[k] *= a[k]; b[k] = fmaxf(b[k], 0.f); b[k] *= b[k]; }
        *(v4u*)(U + (size_t)row * DFF + col) = pack_acc8(a, b); }
    __device__ __forceinline__ void flush(int, float, float) const {} };
struct RowDown { static constexpr bool STATS = true; const bf16* V1; bf16* V2; const float* ST1; float* ST2; const float* g; const float* bb;
    __device__ __forceinline__ void row8(int row, int col, f32x4 a, f32x4 b, float& s, float& s2) const {
        float mu, rs; row_stats(ST1[2 * row], ST1[2 * row + 1], mu, rs); const size_t off = (size_t)row * DM + col; f32x4 x0, x1; unpack8f(*(const v4u*)(V1 + off), x0, x1);
        a = a + ALPHA * ((x0 - mu) * rs * *(const f32x4*)(g + col) + *(const f32x4*)(bb + col)); b = b + ALPHA * ((x1 - mu) * rs * *(const f32x4*)(g + col + 4) + *(const f32x4*)(bb + col + 4));
        sums8(a, b, s, s2); *(v4u*)(V2 + off) = pack_acc8(a, b); }
    __device__ __forceinline__ void flush(int row, float s, float s2) const { unsafeAtomicAdd(ST2 + 2 * row, s); unsafeAtomicAdd(ST2 + 2 * row + 1, s2); } };
struct RowPle { static constexpr bool STATS = false; bf16* O;
    __device__ __forceinline__ void row8(int row, int col, f32x4 a, f32x4 b, float&, float&) const { *(v4u*)(O + (size_t)row * DM + col) = pack_acc8(a, b); }
    __device__ __forceinline__ void flush(int, float, float) const {} };
struct RowGate { static constexpr bool STATS = false; const bf16* V2; const bf16* PLE; float* Y; const float* ST2; const float* cs; const float* bw; const float* g; const float* bb;
    __device__ __forceinline__ void row8(int row, int col, f32x4 a, f32x4 b, float&, float&) const {
        float mu, rs; row_stats(ST2[2 * row], ST2[2 * row + 1], mu, rs); const size_t off = (size_t)row * DM + col; f32x4 x0, x1, p0, p1; unpack8f(*(const v4u*)(V2 + off), x0, x1); unpack8f(*(const v4u*)(PLE + off), p0, p1);
        a = (a - mu * *(const f32x4*)(cs + col)) * rs + *(const f32x4*)(bw + col); b = (b - mu * *(const f32x4*)(cs + col + 4)) * rs + *(const f32x4*)(bw + col + 4);
#pragma unroll
        for (int k = 0; k < 4; ++k) { a[k] = sigmoidf_(a[k]); b[k] = sigmoidf_(b[k]); }
        *(f32x4*)(Y + off) = ALPHA * ((x0 - mu) * rs * *(const f32x4*)(g + col) + *(const f32x4*)(bb + col)) + a * p0;
        *(f32x4*)(Y + off + 4) = ALPHA * ((x1 - mu) * rs * *(const f32x4*)(g + col + 4) + *(const f32x4*)(bb + col + 4)) + b * p1; }
    __device__ __forceinline__ void flush(int, float, float) const {} };
constexpr int NPH = 10;
#ifndef REP_SG
#define REP_SG 1
#endif
#ifndef REP_AP
#define REP_AP 1
#endif
#ifndef REP_AS
#define REP_AS 1
#endif
#ifndef REP_SS
#define REP_SS 1
#endif
#ifndef REP_SO
#define REP_SO 1
#endif
#ifndef MK_ONE_LAUNCH
#define MK_ONE_LAUNCH 1
#endif
__global__ void __launch_bounds__(NWAVES * 64, 2) fwd_kernel(Args args_by_value) {
    extern __shared__ __attribute__((aligned(16))) unsigned char lds[];
    (void)args_by_value;
    const CArgs KA = (CArgs)__builtin_amdgcn_kernarg_segment_ptr();
#define ARGS_NOW(nm) CArgs nm = KA; asm volatile("" : "+s"(nm))
    const int wave_s = __builtin_amdgcn_readfirstlane((int)threadIdx.x >> 6);
    const int G_s = (int)gridDim.x; const int vcu_s = (G_s % 8 == 0) ? ((int)blockIdx.x % 8) * (G_s / 8) + (int)blockIdx.x / 8 : (int)blockIdx.x;
#define PHASE_FRAME() Frame F; { int ln_ = (int)__builtin_amdgcn_mbcnt_hi(~0u, __builtin_amdgcn_mbcnt_lo(~0u, 0u)); asm volatile("" : "+v"(ln_)); \
        F.lds = (LAS unsigned char*)lds; F.MISC = (volatile LAS unsigned*)((LAS unsigned char*)lds + MISC_OFF); F.ctl = (gu32*)(KA->ws + WS_CTL); \
        F.lane = ln_; F.wave = wave_s; F.tid = wave_s * 64 + ln_; F.G = G_s; F.vcu = vcu_s; }
    for (int u = threadIdx.x; u < (LDS_BYTES - LDSCTL_OFF) / 4; u += NWAVES * 64) ((LAS unsigned*)((LAS unsigned char*)lds + LDSCTL_OFF))[u] = 0u;
    __syncthreads();
    const int lo = KA->ph_lo, hi = KA->ph_hi;
#define IS_T0() (wave_s == 0 && (int)__builtin_amdgcn_mbcnt_hi(~0u, __builtin_amdgcn_mbcnt_lo(~0u, 0u)) == 0)
    if (hi - lo > 1) (void)xcd_barrier_post((unsigned*)((gu32*)(KA->ws + WS_CTL) + CW_BAR), (volatile LAS unsigned*)((LAS unsigned char*)lds + MISC_OFF) + 8, IS_T0());
#ifndef PH_MASK
#define PH_MASK 0xfff
#endif
#define IN(k) (((PH_MASK >> (k)) & 1) && lo <= (k) && (k) < hi)
#define SEAM(k) do { if (IN(k) && IN((k) + 1)) { XcdBarrier bb_; bb_.bar = (unsigned*)((gu32*)(KA->ws + WS_CTL) + CW_BAR); bb_.x = xb_xcc_id(); bb_.t0 = IS_T0(); \
        bb_.st = (volatile LAS unsigned*)((LAS unsigned char*)lds + MISC_OFF) + 8; xcd_barrier(bb_); } } while (0)

    if (IN(0)) { PHASE_FRAME(); ARGS_NOW(A); p0_prologue(F, A); SEAM(0); }
    if (IN(1)) {
        PHASE_FRAME(); ARGS_NOW(A); unsigned char* ws = A->ws;
        pg8::Gemm g{(const bf16*)(ws + WS_H0), (const bf16*)(ws + WS_WIN), MP, NPROJ, DM}; pg8::StaticOrder S; S.init(MP, NPROJ, F.G, (int)blockIdx.x);
        EpiProj E{(bf16*)(ws + WS_PROJ), A->out};
        pg8::gemm_phase<EpiProj, pg8::StaticOrder, true, true>(F.lds, g, S, E);
        { RowProj R{(bf16*)(ws + WS_PROJ), A->out};
          for (int rep = 0; rep < REP_SG; ++rep) for (int u = F.vcu; u < 16 * 12; u += F.G) tiled_gemm_unit<128, 128, 2, 4, 1>(F, (const bf16*)(ws + WS_H0), (const bf16*)(ws + WS_WIN), DM, MP + 128 * (u & 7), 128 * (u >> 3), R); }
        SEAM(1);
    }
    if (IN(2)) {
        PHASE_FRAME();
        ARGS_NOW(A); unsigned char* ws = A->ws; const bf16* PROJ = (const bf16*)(ws + WS_PROJ); bf16* MIX = (bf16*)(ws + WS_MIX);
        static_assert(at_bytes<8>() <= RING_BYTES && ST_END <= RING_BYTES && SP_END <= RING_BYTES && AS_MRG + 4 * 34 * 64 * 4 <= RING_BYTES, "phase-2 LDS map");
        Grp<8> G; G.tid = F.tid; G.wave = F.wave; G.lane = F.lane; G.cnt = F.MISC + 16; G.target = 0u;
        for (int rep = 0; rep < REP_AP; ++rep)
        for (int u = F.vcu; u < 256; u += F.G) attn_prompt_unit<8>(G, F.lds, PROJ, MIX, u >> 5, (u >> 2) & 7, u & 3);
        for (int rep = 0; rep < REP_AS; ++rep)
        for (int u = F.vcu; u < 256; u += F.G) { const int task = 4 * u + (F.wave >> 1); attn_sample_task2(F, PROJ, A->in[I_CK], A->in[I_CV], MIX, task >> 3, task & 7, F.wave & 1, F.wave >> 1); }
        for (int rep = 0; rep < REP_SS; ++rep)
        for (int u = F.vcu; u < 256; u += F.G) ssd_states_unit<8>(G, F.lds, A, u >> 5, (u >> 1) & 15, u & 1);
        for (int rep = 0; rep < REP_SS; ++rep)
        for (int u = F.vcu; u < 256; u += F.G) ssd_sample_unit<8>(G, F.lds, A, u >> 1, u & 1);
        float* outp = A->out;
        for (int idx = F.vcu * 512 + F.tid; idx < NBATCH * 3 * CONVD; idx += F.G * 512) { const int b = idx / (3 * CONVD), rem = idx % (3 * CONVD), j = rem / CONVD, ch = rem % CONVD;
            outp[O_CP + idx] = bf2f(PROJ[(size_t)(b * SEQ + SEQ - 3 + j) * NPROJ + CXB + ch]); }
        SEAM(2);
    }
    if (IN(3)) { PHASE_FRAME(); ARGS_NOW(A); for (int u = F.vcu; u < 256; u += F.G) ssd_scan_unit(F, A, u); SEAM(3); }
    if (IN(4)) { PHASE_FRAME(); ARGS_NOW(A); for (int rep = 0; rep < REP_SO; ++rep) for (int u = F.vcu; u < 256; u += F.G) ssd_out_unit(F, A, u >> 5, (u >> 1) & 15, u & 1); SEAM(4); }
    if (IN(5)) {
        PHASE_FRAME(); ARGS_NOW(A); unsigned char* ws = A->ws;
        pg8::Gemm g{(const bf16*)(ws + WS_MIX), (const bf16*)(ws + WS_WOUT), MP, DM, DM}; pg8::StaticOrder S; S.init(MP, DM, F.G, (int)blockIdx.x);
        EpiOut E{(const bf16*)(ws + WS_H0), (bf16*)(ws + WS_V1), (float*)(ws + WS_ST1)};
        pg8::gemm_phase<EpiOut, pg8::StaticOrder, true, true>(F.lds, g, S, E);
        { RowOut R{(const bf16*)(ws + WS_H0), (bf16*)(ws + WS_V1), (float*)(ws + WS_ST1)};
          for (int u = F.vcu; u < 256; u += F.G) tiled_gemm_unit<64, 64, 2, 2, 2>(F, (const bf16*)(ws + WS_MIX), (const bf16*)(ws + WS_WOUT), DM, MP + 64 * (u & 15), 64 * (u >> 4), R); }
        SEAM(5);
    }
    if (IN(6)) {
        PHASE_FRAME(); ARGS_NOW(A); unsigned char* ws = A->ws;
        pg8::Gemm g{(const bf16*)(ws + WS_V1), (const bf16*)(ws + WS_WUP), MP, DFF, DM}; pg8::StaticOrder S; S.init(MP, DFF, F.G, (int)blockIdx.x);
        EpiUp E{(bf16*)(ws + WS_U), (const float*)(ws + WS_ST1), (const float*)(ws + WS_CSUP), (const float*)(ws + WS_BWUP)};
        pg8::gemm_phase<EpiUp, pg8::StaticOrder, true, true>(F.lds, g, S, E);
        { RowUp R{(bf16*)(ws + WS_U), (const float*)(ws + WS_ST1), (const float*)(ws + WS_CSUP), (const float*)(ws + WS_BWUP)};
          for (int rep = 0; rep < REP_SG; ++rep) for (int u = F.vcu; u < 256; u += F.G) tiled_gemm_unit<128, 128, 2, 4, 1>(F, (const bf16*)(ws + WS_V1), (const bf16*)(ws + WS_WUP), DM, MP + 128 * (u & 7), 128 * (u >> 3), R); }
        SEAM(6);
    }
    if (IN(7)) {
        PHASE_FRAME();
        if ((PH_MASK >> 11) & 1) { ARGS_NOW(A); unsigned char* ws = A->ws;
          pg8::Gemm g{(const bf16*)(ws + WS_U), (const bf16*)(ws + WS_WDOWN), MP, DM, DFF}; pg8::StaticOrder S; S.init(MP, DM, F.G, (int)blockIdx.x);
          EpiDown E{(const bf16*)(ws + WS_V1), (bf16*)(ws + WS_V2), (const float*)(ws + WS_ST1), (float*)(ws + WS_ST2), A->in[I_LN1G], A->in[I_LN1B]};
          pg8::gemm_phase<EpiDown, pg8::StaticOrder, true, true>(F.lds, g, S, E);
          RowDown R{(const bf16*)(ws + WS_V1), (bf16*)(ws + WS_V2), (const float*)(ws + WS_ST1), (float*)(ws + WS_ST2), A->in[I_LN1G], A->in[I_LN1B]};
          for (int u = F.vcu; u < 256; u += F.G) tiled_gemm_unit<64, 64, 2, 2, 2>(F, (const bf16*)(ws + WS_U), (const bf16*)(ws + WS_WDOWN), DFF, MP + 64 * (u & 15), 64 * (u >> 4), R); }
        __syncthreads();
        if ((PH_MASK >> 10) & 1) { ARGS_NOW(A); unsigned char* ws = A->ws;
          int kple = DPLE; asm volatile("" : "+s"(kple));
          pg8::Gemm g{(const bf16*)(ws + WS_PE), (const bf16*)(ws + WS_WPLE), MP, DM, kple}; pg8::StaticOrder S; S.init(MP, DM, F.G, (int)blockIdx.x);
          EpiPle E{(bf16*)(ws + WS_PLE)};
          pg8::gemm_phase<EpiPle, pg8::StaticOrder, true, true>(F.lds, g, S, E);
          RowPle R{(bf16*)(ws + WS_PLE)};
          for (int u = F.vcu; u < 256; u += F.G) tiled_gemm_unit<64, 64, 2, 2, 2>(F, (const bf16*)(ws + WS_PE), (const bf16*)(ws + WS_WPLE), kple, MP + 64 * (u & 15), 64 * (u >> 4), R); }
        SEAM(7);
    }
    if (IN(8)) {
        PHASE_FRAME(); ARGS_NOW(A); unsigned char* ws = A->ws;
        pg8::Gemm g{(const bf16*)(ws + WS_V2), (const bf16*)(ws + WS_WGATE), MP, DM, DM}; pg8::StaticOrder S; S.init(MP, DM, F.G, (int)blockIdx.x);
        EpiGate E{(const bf16*)(ws + WS_V2), (const bf16*)(ws + WS_PLE), A->out + O_Y, (const float*)(ws + WS_ST2), (const float*)(ws + WS_CSG), (const float*)(ws + WS_BWG), A->in[I_LN2G], A->in[I_LN2B]};
        pg8::gemm_phase<EpiGate, pg8::StaticOrder, true, true>(F.lds, g, S, E);
        { RowGate R{(const bf16*)(ws + WS_V2), (const bf16*)(ws + WS_PLE), A->out + O_Y, (const float*)(ws + WS_ST2), (const float*)(ws + WS_CSG), (const float*)(ws + WS_BWG), A->in[I_LN2G], A->in[I_LN2B]};
          for (int u = F.vcu; u < 256; u += F.G) tiled_gemm_unit<64, 64, 2, 2, 2>(F, (const bf16*)(ws + WS_V2), (const bf16*)(ws + WS_WGATE), DM, MP + 64 * (u & 15), 64 * (u >> 4), R); }
        SEAM(8);
    }
    if (IN(9)) { PHASE_FRAME(); ARGS_NOW(A); p9_final_ln(F, A); }
#undef IN
#undef SEAM
}

extern "C" void kernel_launch(void* const* d_in, const int* in_sizes, int n_in, void* d_out, int out_size, void* d_ws, size_t ws_size, hipStream_t stream) {
    static int grid = 0;
    if (grid == 0) {
        if (n_in != 28 || out_size != (int)O_END || ws_size < WS_END) { fprintf(stderr, "kernel_launch: unexpected problem shape (n_in %d, out %d, ws %zu); nothing launched\n", n_in, out_size, ws_size); grid = -1; return; }
        int dev = 0, cus = 0, per_cu = 0;
        if (hipGetDevice(&dev) != hipSuccess || hipDeviceGetAttribute(&cus, hipDeviceAttributeMultiprocessorCount, dev) != hipSuccess) { fprintf(stderr, "kernel_launch: device query failed\n"); grid = -1; return; }
        if (hipFuncSetAttribute((const void*)fwd_kernel, hipFuncAttributeMaxDynamicSharedMemorySize, LDS_BYTES) != hipSuccess) { fprintf(stderr, "kernel_launch: hipFuncSetAttribute failed\n"); grid = -1; return; }
        if (hipOccupancyMaxActiveBlocksPerMultiprocessor(&per_cu, (const void*)fwd_kernel, NWAVES * 64, LDS_BYTES) != hipSuccess || per_cu < 1)
            fprintf(stderr, "kernel_launch: note: occupancy query reports %d workgroups per CU\n", per_cu);
        (void)hipGetLastError();
        grid = cus;
    }
    if (grid < 0) return;
    if (hipMemsetAsync((char*)d_ws + WS_CTL, 0, CTL_ZERO_BYTES, stream) != hipSuccess) { fprintf(stderr, "kernel_launch: memset failed\n"); return; }
    Args a{};
    for (int i = 0; i < 28; ++i) a.in[i] = (const float*)d_in[i];
    a.out = (float*)d_out; a.ws = (unsigned char*)d_ws;
#if MK_ONE_LAUNCH
    a.ph_lo = 0; a.ph_hi = NPH;
    hipLaunchKernelGGL(fwd_kernel, dim3(grid), dim3(NWAVES * 64), LDS_BYTES, stream, a);
#else
    for (int p = 0; p < NPH; ++p) { a.ph_lo = p; a.ph_hi = p + 1; hipLaunchKernelGGL(fwd_kernel, dim3(grid), dim3(NWAVES * 64), LDS_BYTES, stream, a); }
#endif
    const hipError_t le = hipPeekAtLastError();
    if (le != hipSuccess) fprintf(stderr, "kernel_launch: launch failed: %s\n", hipGetErrorName(le));
}
```
